# Optimizing an MI355X kernel written in HIP

```python
import math
import jax, jax.numpy as jnp
from jax import lax
import numpy as np

D_MODEL = 1024
BATCH = 4
SEQ = 8192
DEPTH = 1

MOBA_HEADS = 8
MOBA_HEAD_DIM = 64
MOBA_WIDTH = MOBA_HEADS * MOBA_HEAD_DIM
MOBA_BLOCK = 256
MOBA_TOPK = 3
MOBA_QBLOCK = 64
REL_BUCKETS = 32
REL_MAX_DIST = 128
GLA_HEADS = 4
GLA_KEY_DIM = D_MODEL // 2
GLA_VALUE_DIM = D_MODEL
GLA_GATE_RANK = 16
GLA_GATE_NORMALIZER = 16.0
GLA_CHUNK = 64
N_EXPERTS = 32
TOP_K = 4
D_FF = D_MODEL
SWIGLU_ALPHA = 1.702
SWIGLU_LIMIT = 7.0
MOE_BLOCK = 256
N_BRANCHES = 2
EPS = 1e-6
IN_SIZES = (MOBA_WIDTH, MOBA_WIDTH, MOBA_WIDTH,
            GLA_KEY_DIM, GLA_KEY_DIM, GLA_VALUE_DIM, GLA_GATE_RANK, GLA_VALUE_DIM,
            N_BRANCHES * D_MODEL)
D_IN = sum(IN_SIZES)

kernel_name = 'hybrid_moba_gla_moe_block'


def rmsnorm(x, w):
    xf = x.astype(jnp.float32)
    xf = xf * lax.rsqrt(jnp.mean(xf * xf, axis=-1, keepdims=True) + EPS)
    return xf.astype(x.dtype) * w


def modulate(h, shift, scale):
    return h * (1 + scale[:, None, :]) + shift[:, None, :]


def t5_bucket(q_pos, k_pos):
    n = jnp.maximum(q_pos - k_pos, 0)
    max_exact = REL_BUCKETS // 2
    nf = jnp.maximum(n, max_exact).astype(jnp.float32)
    large = max_exact + (jnp.log(nf / max_exact) / math.log(REL_MAX_DIST / max_exact)
                         * (REL_BUCKETS - max_exact)).astype(jnp.int32)
    large = jnp.minimum(large, REL_BUCKETS - 1)
    return jnp.where(n < max_exact, n, large)


def moba_attention(q, k, v, rel_bias):
    B, H, S, hd = q.shape
    n_blk = -(-S // MOBA_BLOCK)
    s_pad = n_blk * MOBA_BLOCK
    pad = ((0, 0), (0, 0), (0, s_pad - S), (0, 0))
    q = jnp.pad(q * hd ** -0.5, pad)
    k = jnp.pad(k, pad)
    v = jnp.pad(v, pad)
    k_blocks = k.reshape(B, H, n_blk, MOBA_BLOCK, hd)
    v_blocks = v.reshape(B, H, n_blk, MOBA_BLOCK, hd)
    k_mean = jnp.mean(k_blocks, axis=3)
    q_blk = jnp.arange(s_pad) // MOBA_BLOCK
    gate = jnp.einsum('bhsd,bhnd->bhsn', q, k_mean).astype(jnp.float32)
    past = jnp.arange(n_blk)[None, :] < q_blk[:, None]
    gate = jnp.where(past, gate, -jnp.inf)
    n_sel = min(MOBA_TOPK, n_blk)
    _, sel = lax.top_k(gate, n_sel)
    b_idx = jnp.arange(B)[:, None, None, None]
    h_idx = jnp.arange(H)[None, :, None, None]
    bias_f = rel_bias.astype(jnp.float32)
    bias_hb = bias_f.T
    blk_off = jnp.arange(MOBA_BLOCK)

    def query_block(t0):
        q_c = lax.dynamic_slice_in_dim(q, t0, MOBA_QBLOCK, axis=2)
        sel_c = lax.dynamic_slice_in_dim(sel, t0, MOBA_QBLOCK, axis=2)
        q_pos = t0 + jnp.arange(MOBA_QBLOCK)
        own0 = (t0 // MOBA_BLOCK) * MOBA_BLOCK
        k_sel = k_blocks[b_idx, h_idx, sel_c]
        v_sel = v_blocks[b_idx, h_idx, sel_c]
        k_pos_sel = sel_c[..., None] * MOBA_BLOCK + blk_off
        bias_sel = bias_hb[h_idx[..., None], t5_bucket(q_pos[:, None, None], k_pos_sel)]
        valid_sel = jnp.arange(n_sel)[None, :] < (q_pos // MOBA_BLOCK)[:, None]
        logit_sel = jnp.einsum('bhqd,bhqnkd->bhqnk', q_c, k_sel).astype(jnp.float32) + bias_sel
        logit_sel = jnp.where(valid_sel[:, :, None], logit_sel, -jnp.inf)
        logit_sel = logit_sel.reshape(B, H, MOBA_QBLOCK, n_sel * MOBA_BLOCK)
        k_own = lax.dynamic_slice_in_dim(k, own0, MOBA_BLOCK, axis=2)
        v_own = lax.dynamic_slice_in_dim(v, own0, MOBA_BLOCK, axis=2)
        k_pos_own = own0 + blk_off
        bias_own = jnp.moveaxis(bias_f[t5_bucket(q_pos[:, None], k_pos_own[None, :])], -1, 0)
        logit_own = jnp.einsum('bhqd,bhkd->bhqk', q_c, k_own).astype(jnp.float32) + bias_own
        logit_own = jnp.where(k_pos_own[None, :] <= q_pos[:, None], logit_own, -jnp.inf)
        p = jax.nn.softmax(jnp.concatenate([logit_sel, logit_own], axis=-1), axis=-1).astype(v.dtype)
        p_sel = p[..., :n_sel * MOBA_BLOCK].reshape(B, H, MOBA_QBLOCK, n_sel, MOBA_BLOCK)
        p_own = p[..., n_sel * MOBA_BLOCK:]
        return (jnp.einsum('bhqnk,bhqnkd->bhqd', p_sel, v_sel)
                + jnp.einsum('bhqk,bhkd->bhqd', p_own, v_own))

    out = lax.map(query_block, jnp.arange(s_pad // MOBA_QBLOCK) * MOBA_QBLOCK)
    return jnp.moveaxis(out, 0, 2).reshape(B, H, s_pad, hd)[:, :, :S]


def gla_chunked(q, k, v, log_a):
    B, S, H, dk = q.shape
    dv = v.shape[-1]
    nc = S // GLA_CHUNK

    def chunks(t):
        return jnp.moveaxis(t.reshape(B, nc, GLA_CHUNK, H, t.shape[-1]), 3, 1)

    dt = v.dtype
    q = chunks(q) * dk ** -0.5
    k = chunks(k)
    v = chunks(v)
    b = jnp.cumsum(chunks(log_a), axis=3)
    b_last = b[:, :, :, -1:, :]
    q_g = q * jnp.exp(b).astype(dt)
    k_g = k * jnp.exp(-b).astype(dt)
    k_end = k * jnp.exp(b_last - b).astype(dt)
    causal = jnp.tril(jnp.ones((GLA_CHUNK, GLA_CHUNK), dtype=bool))
    att = jnp.where(causal, jnp.einsum('bhncd,bhnsd->bhncs', q_g, k_g), 0)
    o_intra = jnp.einsum('bhncs,bhnse->bhnce', att, v)
    decay = jnp.exp(b_last[:, :, :, 0, :]).astype(dt)

    def step(state, xs):
        q_n, k_n, v_n, d_n = xs
        o_n = jnp.einsum('bhcd,bhde->bhce', q_n, state)
        state = d_n[..., None] * state + jnp.einsum('bhcd,bhce->bhde', k_n, v_n)
        return state, o_n

    xs = (jnp.moveaxis(q_g, 2, 0), jnp.moveaxis(k_end, 2, 0), jnp.moveaxis(v, 2, 0), jnp.moveaxis(decay, 2, 0))
    _, o_inter = lax.scan(step, jnp.zeros((B, H, dk, dv), dt), xs)
    o = o_intra + jnp.moveaxis(o_inter, 0, 2)
    return jnp.moveaxis(o, 1, 3).reshape(B, S, H, dv)


def moe_ffn(h, w_router, b_router, w_gate, b_gate, w_up, b_up, w_down, b_down):
    B, S, D = h.shape
    T = B * S
    A = T * TOP_K
    hf = h.reshape(T, D)
    logits = (hf @ w_router + b_router).astype(jnp.float32)
    top_vals, top_idx = lax.top_k(logits, TOP_K)
    weights = jax.nn.softmax(top_vals, axis=-1).astype(h.dtype)
    expert_ids = top_idx.reshape(A)
    token_of = jnp.arange(A) // TOP_K
    order = jnp.argsort(expert_ids)
    sorted_e = expert_ids[order]
    counts = jnp.bincount(expert_ids, length=N_EXPERTS)
    padded = (counts + MOE_BLOCK - 1) // MOE_BLOCK * MOE_BLOCK
    pcum = jnp.cumsum(padded)
    start = jnp.cumsum(counts) - counts
    pstart = pcum - padded
    dest_sorted = pstart[sorted_e] + (jnp.arange(A) - start[sorted_e])
    dest = jnp.zeros((A,), jnp.int32).at[order].set(dest_sorted.astype(jnp.int32))
    n_blocks = (A + MOE_BLOCK - 1) // MOE_BLOCK + N_EXPERTS
    n_pad = n_blocks * MOE_BLOCK
    slot_token = jnp.zeros((n_pad,), jnp.int32).at[dest].set(token_of)
    x_pad = hf[slot_token].reshape(n_blocks, MOE_BLOCK, D)
    block_expert = jnp.minimum(jnp.searchsorted(pcum, jnp.arange(n_blocks) * MOE_BLOCK, side='right'),
                               N_EXPERTS - 1)

    def expert_block(args):
        xb, e = args
        g = jnp.minimum(xb @ w_gate[e] + b_gate[e], SWIGLU_LIMIT)
        u = jnp.clip(xb @ w_up[e] + b_up[e], -SWIGLU_LIMIT, SWIGLU_LIMIT)
        act = g * jax.nn.sigmoid(SWIGLU_ALPHA * g) * (u + 1)
        return act @ w_down[e] + b_down[e]

    y_pad = lax.map(expert_block, (x_pad, block_expert)).reshape(n_pad, D)
    y = y_pad[dest].reshape(T, TOP_K, D)
    return jnp.einsum('tkd,tk->td', y, weights).reshape(B, S, D)


def setup_inputs(seed: int = 0) -> dict:
    key = jax.random.key(seed)
    it = iter(jax.random.split(key, 24))
    L, D, E, F = DEPTH, D_MODEL, N_EXPERTS, D_FF

    def nrm(shape, fan_in, s=1.0):
        return jax.random.normal(next(it), shape, jnp.float32) * (s * fan_in ** -0.5)

    def gain(shape):
        return 1.0 + 0.05 * jax.random.normal(next(it), shape, jnp.float32)

    def small(shape, s=0.01):
        return s * jax.random.normal(next(it), shape, jnp.float32)

    return {
        'x': jax.random.normal(next(it), (BATCH, SEQ, D), jnp.float32),
        'c': jax.random.normal(next(it), (BATCH, D), jnp.float32),
        'rel_bias': small((REL_BUCKETS, MOBA_HEADS), 0.5),
        'w_ada': nrm((L, D, 6 * D), D, 0.5),
        'b_ada': small((L, 6 * D)),
        'norm_mix': gain((L, D)),
        'w_in': nrm((L, D, D_IN), D),
        'w_gk_up': nrm((L, GLA_GATE_RANK, GLA_KEY_DIM), GLA_GATE_RANK),
        'b_gk': small((L, GLA_KEY_DIM)),
        'gla_norm': gain((L, GLA_VALUE_DIM // GLA_HEADS)),
        'w_proj_moba': nrm((L, MOBA_WIDTH, D), MOBA_WIDTH),
        'w_proj_gla': nrm((L, GLA_VALUE_DIM, D), GLA_VALUE_DIM),
        'w_out': nrm((L, D, D), D),
        'norm_ffn': gain((L, D)),
        'w_router': nrm((L, D, E), D),
        'b_router': small((L, E)),
        'w_gate': nrm((L, E, D, F), D),
        'b_gate': small((L, E, F)),
        'w_up': nrm((L, E, D, F), D),
        'b_up': small((L, E, F)),
        'w_down': nrm((L, E, F, D), F),
        'b_down': small((L, E, D)),
        'norm_final': gain((D,)),
    }


def reference(x, c, rel_bias, w_ada, b_ada, norm_mix, w_in, w_gk_up, b_gk, gla_norm,
              w_proj_moba, w_proj_gla, w_out, norm_ffn, w_router, b_router,
              w_gate, b_gate, w_up, b_up, w_down, b_down, norm_final):
    B, S, D = x.shape
    split_at = np.cumsum(IN_SIZES)[:-1].tolist()

    def to_heads(t, n):
        return jnp.moveaxis(t.reshape(B, S, n, -1), 2, 1)

    def gla_heads(t):
        return t.reshape(B, S, GLA_HEADS, -1)

    for l in range(DEPTH):
        mod = jax.nn.silu(c) @ w_ada[l] + b_ada[l]
        sh1, sc1, g1, sh2, sc2, g2 = jnp.split(mod, 6, axis=-1)
        h = modulate(rmsnorm(x, norm_mix[l]), sh1, sc1)
        proj = h @ w_in[l]
        qa, ka, va, qb, kb, vb, gk_low, r, gate_logits = jnp.split(proj, split_at, axis=-1)
        y_a = moba_attention(to_heads(qa, MOBA_HEADS), to_heads(ka, MOBA_HEADS),
                             to_heads(va, MOBA_HEADS), rel_bias)
        y_a = jnp.moveaxis(y_a, 1, 2).reshape(B, S, MOBA_WIDTH)
        log_a = jax.nn.log_sigmoid((gk_low @ w_gk_up[l] + b_gk[l]).astype(jnp.float32)) / GLA_GATE_NORMALIZER
        o_b = gla_chunked(gla_heads(qb), gla_heads(kb), gla_heads(vb), gla_heads(log_a))
        y_b = (rmsnorm(o_b, gla_norm[l]) * jax.nn.silu(gla_heads(r))).reshape(B, S, GLA_VALUE_DIM)
        g_a, g_b = jnp.split(jax.nn.sigmoid(gate_logits), N_BRANCHES, axis=-1)
        mixed = g_a * (y_a @ w_proj_moba[l]) + g_b * (y_b @ w_proj_gla[l])
        x = x + g1[:, None, :] * (mixed @ w_out[l])
        h = modulate(rmsnorm(x, norm_ffn[l]), sh2, sc2)
        x = x + g2[:, None, :] * moe_ffn(h, w_router[l], b_router[l], w_gate[l], b_gate[l],
                                         w_up[l], b_up[l], w_down[l], b_down[l])
    return rmsnorm(x, norm_final)
```

```cpp
#include <hip/hip_runtime.h>
#include <hip/hip_cooperative_groups.h>
#include <cstdio>
#include <cstdint>
#include <math.h>
namespace cg = cooperative_groups;

#define LAS __attribute__((address_space(3)))
typedef unsigned short bf16_t;
typedef short bf16x8 __attribute__((ext_vector_type(8)));
typedef float f32x4 __attribute__((ext_vector_type(4)));
typedef unsigned u32x4 __attribute__((ext_vector_type(4)));
typedef unsigned u32x2 __attribute__((ext_vector_type(2)));

constexpr int NB = 4, SEQ = 8192, DM = 1024, TT = NB * SEQ, DIN = 6672;
constexpr int NPROJ = 6912;
constexpr int NEXP = 32;
constexpr int NWAVES = 8, NTHR = 512;
constexpr size_t MiB = (size_t)1 << 20;

constexpr size_t KiB = 1024;
constexpr size_t WS_CTL = 0;
constexpr size_t WS_MODP = 128 * KiB;
constexpr size_t WS_MOD = 896 * KiB;
constexpr size_t WS_TAB = 992 * KiB;
constexpr size_t WS_KMEAN = 1 * MiB;
constexpr size_t WS_GK = 1 * MiB + 256 * KiB;
constexpr size_t WS_TOPW = 3 * MiB + 256 * KiB;
constexpr size_t WS_DEST = 3 * MiB + 768 * KiB;
constexpr size_t WS_LIST = 4 * MiB + 256 * KiB;
constexpr size_t WS_WIN = 8 * MiB + 256 * KiB;
constexpr size_t WS_WPA = 21 * MiB + 768 * KiB;
constexpr size_t WS_WPB = 22 * MiB + 768 * KiB;
constexpr size_t WS_WOUT = 24 * MiB + 768 * KiB;
constexpr size_t WS_BIG = 28 * MiB;
constexpr size_t WS_GT = WS_BIG;
constexpr size_t WS_R = WS_BIG + 128 * MiB;
constexpr size_t WS_MIX = WS_R;
constexpr size_t WS_VB = WS_BIG + 192 * MiB;
constexpr size_t WS_QB = WS_BIG + 256 * MiB;
constexpr size_t WS_KB = WS_BIG + 288 * MiB;
constexpr size_t WS_QM = WS_BIG + 320 * MiB;
constexpr size_t WS_KM = WS_BIG + 352 * MiB;
constexpr size_t WS_VM = WS_BIG + 384 * MiB;
constexpr size_t WS_XN = WS_BIG + 416 * MiB;
constexpr size_t WS_WD = 508 * MiB;
constexpr size_t WS_ACT = WS_BIG;
constexpr size_t WS_WGU = 304 * MiB;
constexpr size_t WS_H2 = 432 * MiB;
constexpr size_t WS_YA = 304 * MiB;
constexpr size_t WS_NEED = 572 * MiB;
static_assert(WS_WOUT + 2 * MiB <= WS_BIG && WS_XN + 64 * MiB <= WS_WD && WS_WD + 64 * MiB <= WS_NEED, "ws map");
static_assert(WS_ACT + 272 * MiB <= WS_WGU && WS_WGU + 128 * MiB <= WS_H2 && WS_H2 + 64 * MiB <= WS_WD && WS_YA + 160 * MiB <= WS_WD, "moe map");

constexpr int CW_CNT = 0;
constexpr int CW_QCTR = 64;
constexpr int CW_ERR = 128;

constexpr int RING_BYTES = 131072;
constexpr int LDS_IDX = RING_BYTES;
constexpr int LDS_BLKE = LDS_IDX + 17408;
constexpr int LDS_BLKR = LDS_BLKE + 2176;
constexpr int LDS_MISC = LDS_BLKR + 2176;
constexpr int LDS_BYTES = LDS_MISC + 256;
static_assert(LDS_BYTES <= 163840, "LDS");

__device__ __forceinline__ unsigned f2bf(float f) { unsigned u = __builtin_bit_cast(unsigned, f); return (u + 0x7fffu + ((u >> 16) & 1u)) >> 16; }
__device__ __forceinline__ unsigned pk2(float lo, float hi) { return f2bf(lo) | (f2bf(hi) << 16); }
__device__ __forceinline__ float bf2f(unsigned short b) { return __builtin_bit_cast(float, (unsigned)b << 16); }
__device__ __forceinline__ float bflo(unsigned w) { return __builtin_bit_cast(float, w << 16); }
__device__ __forceinline__ float bfhi(unsigned w) { return __builtin_bit_cast(float, w & 0xffff0000u); }
__device__ __forceinline__ float sigm(float x) { return 1.f / (1.f + __expf(-x)); }
__device__ __forceinline__ float wave_sum(float v) {
#pragma unroll
    for (int o = 1; o < 64; o <<= 1) v += __shfl_xor(v, o);
    return v;
}

namespace pg8 {
constexpr int BM = 256, BK = 64, HALF = 128, HTB = HALF * BK * 2, NXCD = 8, WGM = 8;
__host__ __device__ __forceinline__ int lds_byte(int r, int c) { const int st = (r >> 4) * 2 + (c >> 5), rr = r & 15, cc = c & 31, ob = rr * 64 + cc * 2; return st * 1024 + (ob ^ (((ob >> 9) & 1) << 5)); }
__host__ __device__ __forceinline__ void stage_rc(int b, int& R, int& C) { const int st = b / 1024, sb = b % 1024, swz = sb ^ (((sb >> 9) & 1) << 5); R = (st >> 1) * 16 + swz / 64; C = (st & 1) * 32 + (swz % 64) / 2; }
__host__ __device__ __forceinline__ int perm32(int rho) { const int n = rho >> 4, i = rho & 15; return 8 * (i >> 2) + 4 * n + (i & 3); }

struct Unit { int pm, pn, e; const char* A; const char* B; };

struct DenseOrder {
    int nM, nN, nwg, G, c; const char* A0; const char* B0; size_t astep, bstep;
    __device__ void init(int M, int N, int G_, int c_, const void* A, int lda, const void* B, int ldb) { nM = M / BM; nN = N / BM; nwg = nM * nN; G = G_; c = c_; A0 = (const char*)A; B0 = (const char*)B; astep = (size_t)BM * lda * 2; bstep = (size_t)BM * ldb * 2; }
    __device__ bool next(int i, Unit& u) const {
        const long L = (long)i * G + c; if (L >= nwg) return false;
        int wgid = (int)L; { const int q = nwg / NXCD, r = nwg % NXCD, xcd = wgid % NXCD, off = wgid / NXCD; wgid = (xcd < r ? xcd * (q + 1) : r * (q + 1) + (xcd - r) * q) + off; }
        const int nig = WGM * nN, gid = wgid / nig, fm = gid * WGM, gsz = (nM - fm) < WGM ? (nM - fm) : WGM;
        u.pm = fm + ((wgid % nig) % gsz); u.pn = (wgid % nig) / gsz; u.e = 0;
        u.A = A0 + (size_t)u.pm * astep; u.B = B0 + (size_t)u.pn * bstep; return true;
    }
    __device__ __forceinline__ int gidx(int, int) const { return 0; }
};

struct MoeOrder {
    int lo, hi, ncol, G, cp, gather; const char* A0; const char* B0; const LAS int* blkE; const LAS int* idx;
    __device__ bool next(int i, Unit& u) const {
        const long L = (long)i * G + cp; const int b = lo + (int)(L / ncol); if (b >= hi) return false;
        u.pm = b; u.pn = (int)(L % ncol); u.e = blkE[b];
        u.A = gather ? A0 : A0 + (size_t)b * (256 * 1024 * 2); u.B = B0 + ((size_t)u.e * ncol + u.pn) * (size_t)(256 * 1024 * 2); return true;
    }
    __device__ __forceinline__ int gidx(int ui, int row) const { return idx[ui * 256 + row]; }
};

#define PG8_WAIT_V(n) asm volatile("s_waitcnt vmcnt(" #n ")" ::: "memory")
#define PG8_WAIT_L(n) asm volatile("s_waitcnt lgkmcnt(" #n ")" ::: "memory")
#define PG8_BAR __builtin_amdgcn_s_barrier()
#define PG8_SCHED __builtin_amdgcn_sched_barrier(0)

template <class Epi, class Sched, bool GATHER>
__device__ __forceinline__ void gemm_phase(LAS unsigned char* lds, const int lda, const int ldb, const int nt, const Sched& S, const Epi& E) {
    const int tid = threadIdx.x, wid = __builtin_amdgcn_readfirstlane(tid >> 6), lane = tid & 63, wr = wid >> 2, wc = wid & 3, fr = lane & 15, fq = lane >> 4;
    unsigned voffA[2], voffA1[2], voffB[2]; int RA[2], CA[2];
#pragma unroll
    for (int i = 0; i < 2; ++i) { int R, C; stage_rc(tid * 16 + i * 8192, R, C); const int Rb = Epi::PERM ? ((R & ~31) + perm32(R & 31)) : R;
        RA[i] = R; CA[i] = C; voffA[i] = (unsigned)(R * lda + C) * 2u; voffA1[i] = voffA[i]; voffB[i] = (unsigned)(Rb * ldb + C) * 2u; }
    const size_t kstep = (size_t)(BK * 2);
    const size_t hstepA = GATHER ? 0 : (size_t)HALF * lda * 2, hstepB = (size_t)HALF * ldb * 2;
    const unsigned ldsw = (unsigned)wid * 1024u;
    const int aoff = lds_byte(wr * 64 + fr, fq * 8), boff = lds_byte(wc * 32 + fr, fq * 8);
#define PG8_SA(b, h) (((b) * 2 + (h)) * HTB)
#define PG8_SB(b, h) ((4 + (b) * 2 + (h)) * HTB)
#define PG8_STAGE(bufoff, gbase, voff) do { _Pragma("unroll") for (int _i = 0; _i < 2; ++_i) \
        __builtin_amdgcn_global_load_lds((const unsigned*)((const char*)(gbase) + (voff)[_i]), (LAS unsigned*)(lds + (bufoff) + ldsw + _i * 8192), 16, 0, 0); } while (0)
#define PG8_LDA(dst, b, h) do { _Pragma("unroll") for (int m = 0; m < 4; ++m) _Pragma("unroll") for (int k = 0; k < 2; ++k) dst[m][k] = *(const LAS bf16x8*)(lds + PG8_SA(b, h) + aoff + m * 2048 + k * 1024); } while (0)
#define PG8_LDB(dst, b, h) do { _Pragma("unroll") for (int n = 0; n < 2; ++n) _Pragma("unroll") for (int k = 0; k < 2; ++k) dst[n][k] = *(const LAS bf16x8*)(lds + PG8_SB(b, h) + boff + n * 2048 + k * 1024); } while (0)
#define PG8_MMA(ai, bj, At, Bt) do { __builtin_amdgcn_s_setprio(1); _Pragma("unroll") for (int m = 0; m < 4; ++m) _Pragma("unroll") for (int n = 0; n < 2; ++n) _Pragma("unroll") for (int k = 0; k < 2; ++k) \
        acc[ai][bj][m][n] = __builtin_amdgcn_mfma_f32_16x16x32_bf16(Bt[n][k], At[m][k], acc[ai][bj][m][n], 0, 0, 0); __builtin_amdgcn_s_setprio(0); } while (0)
#define PG8_GLOAD(uix) do { if constexpr (GATHER) { _Pragma("unroll") for (int _i = 0; _i < 2; ++_i) { \
        voffA[_i] = (unsigned)(S.gidx(uix, RA[_i]) * lda + CA[_i]) * 2u; voffA1[_i] = (unsigned)(S.gidx(uix, 128 + RA[_i]) * lda + CA[_i]) * 2u; } } } while (0)
    Unit cur, nxt; int ui = 0;
    if (!S.next(0, cur)) return;
    f32x4 acc[2][2][4][2];
#pragma unroll
    for (int a = 0; a < 2; ++a)
#pragma unroll
        for (int b = 0; b < 2; ++b)
#pragma unroll
            for (int m = 0; m < 4; ++m)
#pragma unroll
                for (int n = 0; n < 2; ++n) acc[a][b][m][n] = (f32x4){0.f, 0.f, 0.f, 0.f};
    bf16x8 At[4][2], B0[2][2], B1[2][2];
    const char* cA = cur.A; const char* cB = cur.B;
    PG8_GLOAD(0);
    PG8_STAGE(PG8_SB(0, 0), cB, voffB); PG8_STAGE(PG8_SB(0, 1), cB + hstepB, voffB); PG8_STAGE(PG8_SA(0, 0), cA, voffA); PG8_STAGE(PG8_SA(0, 1), cA + hstepA, voffA1);
    if (wr == 1) PG8_BAR;
    PG8_WAIT_V(2); PG8_BAR;
    PG8_STAGE(PG8_SB(1, 0), cB + kstep, voffB); PG8_STAGE(PG8_SA(1, 0), cA + kstep, voffA); PG8_STAGE(PG8_SB(1, 1), cB + hstepB + kstep, voffB);
    PG8_WAIT_V(6); PG8_BAR;
    for (;;) {
        const bool has_next = S.next(ui + 1, nxt);
        const char* nA = has_next ? nxt.A : cA; const char* nB = has_next ? nxt.B : cB;
        for (int t = 0; t < nt; t += 2) {
            const bool last = (t == nt - 2);
            const char* a1 = cA + (size_t)(t + 1) * kstep;
            const char* a2 = last ? nA : cA + (size_t)(t + 2) * kstep; const char* b2 = last ? nB : cB + (size_t)(t + 2) * kstep;
            const char* a3 = a2 + kstep; const char* b3 = b2 + kstep;
            PG8_LDB(B0, 0, 0); PG8_LDB(B1, 0, 1); PG8_SCHED; PG8_LDA(At, 0, 0); PG8_STAGE(PG8_SA(1, 1), a1 + hstepA, voffA1);
            if (GATHER && last && has_next) { PG8_GLOAD(ui + 1); }
            PG8_WAIT_V(8); PG8_WAIT_L(0); PG8_BAR; PG8_MMA(0, 0, At, B0); PG8_MMA(0, 1, At, B1); PG8_BAR; PG8_SCHED;
            PG8_LDA(At, 0, 1); PG8_STAGE(PG8_SB(0, 0), b2, voffB); PG8_STAGE(PG8_SB(0, 1), b2 + hstepB, voffB); PG8_STAGE(PG8_SA(0, 0), a2, voffA);
            PG8_WAIT_V(8); PG8_WAIT_L(0); PG8_BAR; PG8_MMA(1, 0, At, B0); PG8_MMA(1, 1, At, B1); PG8_BAR; PG8_SCHED;
            PG8_LDB(B0, 1, 0); PG8_LDB(B1, 1, 1); PG8_SCHED; PG8_LDA(At, 1, 0); PG8_STAGE(PG8_SA(0, 1), a2 + hstepA, voffA1);
            PG8_WAIT_V(8); PG8_WAIT_L(0); PG8_BAR; PG8_MMA(0, 0, At, B0); PG8_MMA(0, 1, At, B1); PG8_BAR; PG8_SCHED;
            PG8_LDA(At, 1, 1); PG8_STAGE(PG8_SB(1, 0), b3, voffB); PG8_STAGE(PG8_SB(1, 1), b3 + hstepB, voffB); PG8_STAGE(PG8_SA(1, 0), a3, voffA);
            PG8_WAIT_V(8); PG8_WAIT_L(0); PG8_BAR; PG8_MMA(1, 0, At, B0); PG8_MMA(1, 1, At, B1); PG8_BAR; PG8_SCHED;
        }
        if (wr == 0) PG8_BAR;
        E(acc, cur, wr, wc, fr, fq);
        if (!has_next) break;
#pragma unroll
        for (int a = 0; a < 2; ++a)
#pragma unroll
            for (int b = 0; b < 2; ++b)
#pragma unroll
                for (int m = 0; m < 4; ++m)
#pragma unroll
                    for (int n = 0; n < 2; ++n) acc[a][b][m][n] = (f32x4){0.f, 0.f, 0.f, 0.f};
        cur = nxt; cA = nA; cB = nB; ++ui;
        if (wr == 1) PG8_BAR;
    }
    PG8_WAIT_V(0);
    PG8_BAR;
#undef PG8_SA
#undef PG8_SB
#undef PG8_STAGE
#undef PG8_LDA
#undef PG8_LDB
#undef PG8_MMA
#undef PG8_GLOAD
}
}

typedef f32x4 Acc[2][2][4][2];
__device__ __forceinline__ u32x4 pack8(f32x4 a, f32x4 b) { u32x4 w; w.x = pk2(a[0], a[1]); w.y = pk2(a[2], a[3]); w.z = pk2(b[0], b[1]); w.w = pk2(b[2], b[3]); return w; }
__device__ __forceinline__ f32x4 silu4(f32x4 v) { return (f32x4){v[0] * sigm(v[0]), v[1] * sigm(v[1]), v[2] * sigm(v[2]), v[3] * sigm(v[3])}; }
__device__ __forceinline__ f32x4 sigm4(f32x4 v) { return (f32x4){sigm(v[0]), sigm(v[1]), sigm(v[2]), sigm(v[3])}; }

struct EpiProj {
    static constexpr bool PERM = true;
    unsigned char* ws;
    __device__ __forceinline__ void operator()(const Acc& acc, const pg8::Unit& u, int wr, int wc, int fr, int fq) const {
        const int pn = u.pn; size_t boff; int ldc, ct, fn = 0; float sc = 1.f;
        if (pn < 2) { boff = WS_QM; ldc = 512; ct = pn; sc = 0.125f; }
        else if (pn < 4) { boff = WS_KM; ldc = 512; ct = pn - 2; }
        else if (pn < 6) { boff = WS_VM; ldc = 512; ct = pn - 4; }
        else if (pn < 8) { boff = WS_QB; ldc = 512; ct = pn - 6; sc = 0.08838834764831845f; }
        else if (pn < 10) { boff = WS_KB; ldc = 512; ct = pn - 8; }
        else if (pn < 14) { boff = WS_VB; ldc = 1024; ct = pn - 10; }
        else if (pn < 18) { boff = WS_R; ldc = 1024; ct = pn - 14; fn = 1; }
        else if (pn < 26) { boff = WS_GT; ldc = 2048; ct = pn - 18; fn = 2; }
        else {
            if (wc == 0 && fq < 2) {
                float* gk = (float*)(ws + WS_GK);
#pragma unroll
                for (int ai = 0; ai < 2; ++ai)
#pragma unroll
                    for (int m = 0; m < 4; ++m) { const int r = u.pm * 256 + ai * 128 + wr * 64 + m * 16 + fr;
                        *(f32x4*)(gk + (size_t)r * 16 + 8 * fq) = acc[ai][0][m][0]; *(f32x4*)(gk + (size_t)r * 16 + 8 * fq + 4) = acc[ai][0][m][1]; }
            }
            return;
        }
        bf16_t* base = (bf16_t*)(ws + boff);
        const int col0 = ct * 256 + wc * 32 + 8 * fq;
#pragma unroll
        for (int ai = 0; ai < 2; ++ai)
#pragma unroll
            for (int m = 0; m < 4; ++m) { bf16_t* rowp = base + (size_t)(u.pm * 256 + ai * 128 + wr * 64 + m * 16 + fr) * ldc + col0;
#pragma unroll
                for (int bj = 0; bj < 2; ++bj) { f32x4 v0 = acc[ai][bj][m][0] * sc, v1 = acc[ai][bj][m][1] * sc;
                    if (fn == 1) { v0 = silu4(v0); v1 = silu4(v1); } else if (fn == 2) { v0 = sigm4(v0); v1 = sigm4(v1); }
                    *(u32x4*)(rowp + bj * 128) = pack8(v0, v1); } }
    }
};

template <int MODE> struct EpiMix {
    static constexpr bool PERM = true;
    const bf16_t* gt; bf16_t* mix;
    __device__ __forceinline__ void operator()(const Acc& acc, const pg8::Unit& u, int wr, int wc, int fr, int fq) const {
        const int col0 = u.pn * 256 + wc * 32 + 8 * fq;
#pragma unroll
        for (int ai = 0; ai < 2; ++ai)
#pragma unroll
            for (int m = 0; m < 4; ++m) { const size_t row = (size_t)(u.pm * 256 + ai * 128 + wr * 64 + m * 16 + fr);
#pragma unroll
                for (int bj = 0; bj < 2; ++bj) {
                    const u32x4 g = *(const u32x4*)(gt + row * 2048 + MODE * 1024 + col0 + bj * 128);
                    f32x4 v0 = acc[ai][bj][m][0], v1 = acc[ai][bj][m][1];
                    v0 = (f32x4){v0[0] * bflo(g.x), v0[1] * bfhi(g.x), v0[2] * bflo(g.y), v0[3] * bfhi(g.y)};
                    v1 = (f32x4){v1[0] * bflo(g.z), v1[1] * bfhi(g.z), v1[2] * bflo(g.w), v1[3] * bfhi(g.w)};
                    bf16_t* op = mix + row * 1024 + col0 + bj * 128;
                    if (MODE == 1) { const u32x4 p = *(const u32x4*)op;
                        v0 += (f32x4){bflo(p.x), bfhi(p.x), bflo(p.y), bfhi(p.y)}; v1 += (f32x4){bflo(p.z), bfhi(p.z), bflo(p.w), bfhi(p.w)}; }
                    *(u32x4*)op = pack8(v0, v1); } }
    }
};

struct EpiX1 {
    static constexpr bool PERM = false;
    const float* x; const float* g1; float* x1;
    __device__ __forceinline__ void operator()(const Acc& acc, const pg8::Unit& u, int wr, int wc, int fr, int fq) const {
        const int col0 = u.pn * 256 + wc * 32 + 4 * fq; const int b = u.pm >> 5;
#pragma unroll
        for (int bj = 0; bj < 2; ++bj)
#pragma unroll
            for (int n = 0; n < 2; ++n) { const int c = col0 + bj * 128 + n * 16; const f32x4 gv = *(const f32x4*)(g1 + b * 6144 + c);
#pragma unroll
                for (int ai = 0; ai < 2; ++ai)
#pragma unroll
                    for (int m = 0; m < 4; ++m) { const size_t off = (size_t)(u.pm * 256 + ai * 128 + wr * 64 + m * 16 + fr) * 1024 + c;
                        *(f32x4*)(x1 + off) = *(const f32x4*)(x + off) + gv * acc[ai][bj][m][n]; } }
    }
};

struct EpiAct {
    static constexpr bool PERM = true;
    const float* bg; const float* bu; bf16_t* act;
    __device__ __forceinline__ void operator()(const Acc& acc, const pg8::Unit& u, int wr, int wc, int fr, int fq) const {
        const int col0 = u.pn * 128 + wc * 32 + 8 * fq;
        const f32x4 g0 = *(const f32x4*)(bg + u.e * 1024 + col0), g1 = *(const f32x4*)(bg + u.e * 1024 + col0 + 4);
        const f32x4 u0 = *(const f32x4*)(bu + u.e * 1024 + col0), u1 = *(const f32x4*)(bu + u.e * 1024 + col0 + 4);
#pragma unroll
        for (int ai = 0; ai < 2; ++ai)
#pragma unroll
            for (int m = 0; m < 4; ++m) { const size_t row = (size_t)u.pm * 256 + ai * 128 + wr * 64 + m * 16 + fr;
                f32x4 a0, a1;
#pragma unroll
                for (int j = 0; j < 4; ++j) {
                    float g = fminf(acc[ai][0][m][0][j] + g0[j], 7.f), uu = fminf(fmaxf(acc[ai][1][m][0][j] + u0[j], -7.f), 7.f);
                    a0[j] = g * sigm(1.702f * g) * (uu + 1.f);
                    g = fminf(acc[ai][0][m][1][j] + g1[j], 7.f); uu = fminf(fmaxf(acc[ai][1][m][1][j] + u1[j], -7.f), 7.f);
                    a1[j] = g * sigm(1.702f * g) * (uu + 1.f);
                }
                *(u32x4*)(act + row * 1024 + col0) = pack8(a0, a1); }
    }
};

struct EpiDown {
    static constexpr bool PERM = true;
    const float* bd; bf16_t* y; int blk0;
    __device__ __forceinline__ void operator()(const Acc& acc, const pg8::Unit& u, int wr, int wc, int fr, int fq) const {
        const int col0 = u.pn * 256 + wc * 32 + 8 * fq;
#pragma unroll
        for (int bj = 0; bj < 2; ++bj) { const int c = col0 + bj * 128;
            const f32x4 b0 = *(const f32x4*)(bd + u.e * 1024 + c), b1 = *(const f32x4*)(bd + u.e * 1024 + c + 4);
#pragma unroll
            for (int ai = 0; ai < 2; ++ai)
#pragma unroll
                for (int m = 0; m < 4; ++m) { const size_t row = (size_t)(u.pm - blk0) * 256 + ai * 128 + wr * 64 + m * 16 + fr;
                    *(u32x4*)(y + row * 1024 + c) = pack8(acc[ai][bj][m][0] + b0, acc[ai][bj][m][1] + b1); } }
    }
};

struct Args {
    const float* in[23]; float* out; unsigned char* ws;
};

__device__ __forceinline__ void transpose_item(const float* W, int ldw, int sc0, int k0, bf16_t* WT, int K, int dr0, LAS float* scr, int lane, int ncols) {
#pragma unroll 8
    for (int i = 0; i < 32; ++i) { const int kk = 2 * i + (lane >> 5); const int cc = lane & 31;
        scr[kk * 33 + cc] = (cc < ncols) ? W[(size_t)(k0 + kk) * ldw + sc0 + cc] : 0.f; }
    asm volatile("s_waitcnt lgkmcnt(0)" ::: "memory");
    const int c = lane & 7;
#pragma unroll
    for (int j = 0; j < 4; ++j) { const int n = (lane >> 3) + 8 * j; const LAS float* s = scr + (8 * c) * 33 + n;
        u32x4 o; o.x = pk2(s[0 * 33], s[1 * 33]); o.y = pk2(s[2 * 33], s[3 * 33]); o.z = pk2(s[4 * 33], s[5 * 33]); o.w = pk2(s[6 * 33], s[7 * 33]);
        *(u32x4*)(WT + (size_t)(dr0 + n) * K + k0 + 8 * c) = o; }
    asm volatile("s_waitcnt lgkmcnt(0)" ::: "memory");
}

__global__ void __launch_bounds__(NTHR, 2) mega_fwd(Args args) {
    extern __shared__ __attribute__((aligned(16))) unsigned char lds_raw[];
    LAS unsigned char* lds = (LAS unsigned char*)lds_raw;
    cg::grid_group grid = cg::this_grid();
    const int tid = threadIdx.x, lane = tid & 63, wave = __builtin_amdgcn_readfirstlane(tid >> 6);
    const int G = gridDim.x, bx = blockIdx.x;
    const int vcu = (G % 8 == 0) ? (bx % 8) * (G / 8) + bx / 8 : bx;
    const int gw = vcu * NWAVES + wave, NGW = G * NWAVES;
    unsigned char* ws = args.ws;
    const float* x = args.in[0]; const float* cvec = args.in[1]; const float* rel_bias = args.in[2]; const float* w_ada = args.in[3]; const float* b_ada = args.in[4];
    const float* norm_mix = args.in[5]; const float* w_in = args.in[6]; const float* w_gk_up = args.in[7]; const float* b_gk = args.in[8]; const float* gla_norm = args.in[9];
    const float* w_pa = args.in[10]; const float* w_pb = args.in[11]; const float* w_out = args.in[12]; const float* norm_ffn = args.in[13]; const float* w_router = args.in[14];
    const float* b_router = args.in[15]; const float* w_gate = args.in[16]; const float* b_gate = args.in[17]; const float* w_up = args.in[18]; const float* b_up = args.in[19];
    const float* w_down = args.in[20]; const float* b_down = args.in[21]; const float* norm_final = args.in[22];
    float* out = args.out;
    unsigned* ctl = (unsigned*)(ws + WS_CTL);
    float* modp = (float*)(ws + WS_MODP); float* mod = (float*)(ws + WS_MOD); float* tab = (float*)(ws + WS_TAB); float* kmean = (float*)(ws + WS_KMEAN);
    float* gkl = (float*)(ws + WS_GK); float* topw = (float*)(ws + WS_TOPW); int* dest = (int*)(ws + WS_DEST); int* list = (int*)(ws + WS_LIST);
    bf16_t* WinT = (bf16_t*)(ws + WS_WIN); bf16_t* WpaT = (bf16_t*)(ws + WS_WPA); bf16_t* WpbT = (bf16_t*)(ws + WS_WPB); bf16_t* WoutT = (bf16_t*)(ws + WS_WOUT);
    bf16_t* WdT = (bf16_t*)(ws + WS_WD); bf16_t* WguT = (bf16_t*)(ws + WS_WGU);
    bf16_t* XN = (bf16_t*)(ws + WS_XN); bf16_t* Qm = (bf16_t*)(ws + WS_QM); bf16_t* Km = (bf16_t*)(ws + WS_KM); bf16_t* Vm = (bf16_t*)(ws + WS_VM);
    bf16_t* QBb = (bf16_t*)(ws + WS_QB); bf16_t* KBb = (bf16_t*)(ws + WS_KB); bf16_t* VBb = (bf16_t*)(ws + WS_VB); bf16_t* Rb = (bf16_t*)(ws + WS_R); bf16_t* GT = (bf16_t*)(ws + WS_GT);
    bf16_t* MIX = (bf16_t*)(ws + WS_MIX); bf16_t* H2 = (bf16_t*)(ws + WS_H2); bf16_t* ACT = (bf16_t*)(ws + WS_ACT); bf16_t* YA = (bf16_t*)(ws + WS_YA); bf16_t* YBr = (bf16_t*)(ws + WS_ACT);
    bf16_t* ya = (bf16_t*)out;
    bf16_t* yb = (bf16_t*)((unsigned char*)out + 32 * MiB);
    LAS float* scr = (LAS float*)(lds + wave * 16384);

    {
        for (int it = gw; it < 96 * 8; it += NGW) {
            const int cgp = it % 96, kc = it / 96; const int col = cgp * 64 + lane;
            float a0 = 0.f, a1 = 0.f, a2 = 0.f, a3 = 0.f;
            for (int k = kc * 128; k < kc * 128 + 128; ++k) {
                const float w = w_ada[(size_t)k * 6144 + col];
                const float c0 = cvec[k], c1 = cvec[1024 + k], c2 = cvec[2048 + k], c3 = cvec[3072 + k];
                a0 += c0 * sigm(c0) * w; a1 += c1 * sigm(c1) * w; a2 += c2 * sigm(c2) * w; a3 += c3 * sigm(c3) * w;
            }
            float* mp = modp + (size_t)kc * (4 * 6144) + col;
            mp[0] = a0; mp[6144] = a1; mp[2 * 6144] = a2; mp[3 * 6144] = a3;
        }
        if (gw == NGW - 1) {
            for (int i = lane; i < 8 * 128; i += 64) { const int h = i >> 7, n = i & 127; int bkt;
                if (n < 16) bkt = n; else { const int l = 16 + (int)(logf((float)n / 16.f) / logf(8.f) * 16.f); bkt = l < 31 ? l : 31; }
                tab[i] = rel_bias[bkt * 8 + h]; }
            if (lane < 8) tab[1024 + lane] = rel_bias[31 * 8 + lane];
        }
        constexpr int I_IN = 16 * 208, I_GK = 16, I_PA = 8 * 32, I_PB = 16 * 32, I_OUT = 16 * 32, I_WD = 32 * 16 * 32;
        constexpr int NIT = I_IN + I_GK + I_PA + I_PB + I_OUT + I_WD;
        for (int it = gw; it < NIT; it += NGW) {
            int r = it;
            if (r < I_IN) { const int kb = r / 208, nb = r % 208; const int dr0 = nb * 32; const int sc0 = dr0 < 3584 ? dr0 : dr0 + 16;
                transpose_item(w_in, DIN, sc0, kb * 64, WinT, 1024, dr0, scr, lane, 32); continue; } r -= I_IN;
            if (r < I_GK) { transpose_item(w_in, DIN, 3584, r * 64, WinT, 1024, 6656, scr, lane, 16); continue; } r -= I_GK;
            if (r < I_PA) { const int kb = r / 32, nb = r % 32; transpose_item(w_pa, 1024, nb * 32, kb * 64, WpaT, 512, nb * 32, scr, lane, 32); continue; } r -= I_PA;
            if (r < I_PB) { const int kb = r / 32, nb = r % 32; transpose_item(w_pb, 1024, nb * 32, kb * 64, WpbT, 1024, nb * 32, scr, lane, 32); continue; } r -= I_PB;
            if (r < I_OUT) { const int kb = r / 32, nb = r % 32; transpose_item(w_out, 1024, nb * 32, kb * 64, WoutT, 1024, nb * 32, scr, lane, 32); continue; } r -= I_OUT;
            { const int e = r / 512, q = r % 512, kb = q / 32, nb = q % 32;
              transpose_item(w_down + (size_t)e * 1024 * 1024, 1024, nb * 32, kb * 64, WdT + (size_t)e * 1024 * 1024, 1024, nb * 32, scr, lane, 32); }
        }
        for (int i = gw * 64 + lane; i < 224 * 128; i += NGW * 64) *(u32x4*)(WinT + (size_t)6688 * 1024 + (size_t)i * 8) = (u32x4){0u, 0u, 0u, 0u};
    }
    grid.sync();

    {
        LAS float* smod = (LAS float*)lds;
        for (int i = tid; i < 4 * 2048; i += NTHR) { const int b = i >> 11, c = i & 2047; float s = b_ada[c];
#pragma unroll
            for (int kc = 0; kc < 8; ++kc) s += modp[(size_t)kc * (4 * 6144) + b * 6144 + c];
            smod[i] = s; }
        for (int i = bx * NTHR + tid; i < 4 * 6144; i += G * NTHR) { const int c = i % 6144; float s = b_ada[c];
#pragma unroll
            for (int kc = 0; kc < 8; ++kc) s += modp[(size_t)kc * (4 * 6144) + i];
            mod[i] = s; }
        __syncthreads();
        for (int m = gw; m < TT; m += NGW) {
            const int b = m >> 13;
            const f32x4* xr = (const f32x4*)(x + (size_t)m * DM) + lane;
            f32x4 v[4]; float s = 0.f;
#pragma unroll
            for (int j = 0; j < 4; ++j) { v[j] = xr[64 * j]; s += (v[j][0] * v[j][0] + v[j][1] * v[j][1]) + (v[j][2] * v[j][2] + v[j][3] * v[j][3]); }
            const float rs = rsqrtf(wave_sum(s) * (1.f / DM) + 1e-6f);
            unsigned long long* o8 = (unsigned long long*)(XN + (size_t)m * DM) + lane;
#pragma unroll
            for (int j = 0; j < 4; ++j) { const int c = 256 * j + 4 * lane;
                const f32x4 w = *(const f32x4*)(norm_mix + c); const f32x4 sh = *(const LAS f32x4*)(smod + b * 2048 + c), sc = *(const LAS f32x4*)(smod + b * 2048 + 1024 + c);
                const f32x4 h = (v[j] * rs) * w * (sc + 1.f) + sh;
                o8[64 * j] = (unsigned long long)pk2(h[0], h[1]) | ((unsigned long long)pk2(h[2], h[3]) << 32); }
        }
    }
    grid.sync();

    {
        pg8::DenseOrder S; S.init(TT, NPROJ, G, bx, XN, 1024, WinT, 1024);
        EpiProj E{ws};
        pg8::gemm_phase<EpiProj, pg8::DenseOrder, false>(lds, 1024, 1024, 16, S, E);
    }
    grid.sync();

    for (int it = gw; it < 32 * 32; it += NGW) {
        const int bh = it >> 5, n = it & 31, b = bh >> 3, h = bh & 7;
        const bf16_t* kp = Km + (size_t)(b * SEQ + n * 256) * 512 + h * 64 + lane;
        float s = 0.f;
        for (int i = 0; i < 256; ++i) s += bf2f(kp[(size_t)i * 512]);
        kmean[(size_t)it * 64 + lane] = s * (1.f / 256.f);
    }
    grid.sync();

    if (bx < 16) {
        const int b = bx >> 2, h = bx & 3;
        const int e = tid & 255, dg = tid >> 8;
        LAS float* sa = (LAS float*)lds;
        LAS float* sk = sa + 16 * 128; LAS float* sqq = sk + 16 * 128;
        LAS float* sv = sqq + 16 * 128;
        LAS float* part = sv + 16 * 256;
        LAS float* swg = part + 16 * 2 * 256;
        LAS float* red = swg + 16 * 128;
        for (int i = tid; i < 16 * 128; i += NTHR) swg[i] = w_gk_up[(i >> 7) * 512 + h * 128 + (i & 127)];
        float st[64];
#pragma unroll
        for (int i = 0; i < 64; ++i) st[i] = 0.f;
        const float gn = gla_norm[e];
        __syncthreads();
        for (int t0 = 0; t0 < SEQ; t0 += 16) {
            for (int i = tid; i < 16 * 128; i += NTHR) { const int tt = i >> 7, d = i & 127; const size_t row = (size_t)(b * SEQ + t0 + tt);
                float s = b_gk[h * 128 + d];
#pragma unroll
                for (int r = 0; r < 16; ++r) s += gkl[row * 16 + r] * swg[r * 128 + d];
                const float ls = fminf(s, 0.f) - log1pf(__expf(-fabsf(s)));
                sa[i] = __expf(ls * (1.f / 16.f));
                sqq[i] = bf2f(QBb[row * 512 + h * 128 + d]);
                sk[i] = bf2f(KBb[row * 512 + h * 128 + d]); }
            for (int i = tid; i < 16 * 256; i += NTHR) { const int tt = i >> 8, ee = i & 255; sv[i] = bf2f(VBb[(size_t)(b * SEQ + t0 + tt) * 1024 + h * 256 + ee]); }
            __syncthreads();
            for (int tt = 0; tt < 16; ++tt) {
                const float v = sv[tt * 256 + e]; float o = 0.f;
#pragma unroll
                for (int i = 0; i < 64; ++i) { const int d = dg * 64 + i; st[i] = sa[tt * 128 + d] * st[i] + sk[tt * 128 + d] * v; o += sqq[tt * 128 + d] * st[i]; }
                part[(tt * 2 + dg) * 256 + e] = o;
            }
            __syncthreads();
#pragma unroll
            for (int q = 0; q < 2; ++q) { const int tt = wave * 2 + q; float ov[4]; float ss = 0.f;
#pragma unroll
                for (int j = 0; j < 4; ++j) { const int ee = lane + 64 * j; ov[j] = part[(tt * 2) * 256 + ee] + part[(tt * 2 + 1) * 256 + ee]; ss += ov[j] * ov[j]; }
                const float rs = rsqrtf(wave_sum(ss) * (1.f / 256.f) + 1e-6f); const size_t row = (size_t)(b * SEQ + t0 + tt);
#pragma unroll
                for (int j = 0; j < 4; ++j) { const int ee = lane + 64 * j;
                    yb[row * 1024 + h * 256 + ee] = (bf16_t)f2bf(ov[j] * rs * gla_norm[ee] * bf2f(Rb[row * 1024 + h * 256 + ee])); } }
            __syncthreads();
        }
        (void)gn; (void)red;
    }
    {
        LAS float* sq = (LAS float*)(lds + 65536) + wave * 64;
        LAS float* sp = (LAS float*)(lds + 65536 + 2048) + wave * 1024;
        LAS int* sch = (LAS int*)(lds + LDS_MISC);
        for (;;) {
            __syncthreads();
            if (tid == 0) sch[0] = (int)atomicAdd(&ctl[CW_QCTR], 1u);
            __syncthreads();
            const int ch = sch[0];
            if (ch >= 4096) break;
            const int bh = ch >> 7, t00 = (ch & 127) * 64, b = bh >> 3, h = bh & 7;
            for (int qi = 0; qi < 8; ++qi) {
                const int t = t00 + wave * 8 + qi, j = t >> 8;
                sq[lane] = bf2f(Qm[(size_t)(b * SEQ + t) * 512 + h * 64 + lane]);
                asm volatile("s_waitcnt lgkmcnt(0)" ::: "memory");
                float g = -INFINITY;
                if (lane < j) { const float* km = kmean + ((size_t)bh * 32 + lane) * 64; float s = 0.f; for (int d = 0; d < 64; ++d) s += sq[d] * km[d]; g = s; }
                int sel0, sel1, sel2;
                { int sel[3];
#pragma unroll
                  for (int i = 0; i < 3; ++i) { float v = g; int idx = lane;
                      for (int off = 32; off; off >>= 1) { const float ov = __shfl_xor(v, off); const int oi = __shfl_xor(idx, off); if (ov > v || (ov == v && oi < idx)) { v = ov; idx = oi; } }
                      sel[i] = idx; if (lane == idx) g = -INFINITY; }
                  sel0 = sel[0]; sel1 = sel[1]; sel2 = sel[2]; }
                const int nsel = j < 3 ? j : 3;
                float mx = -INFINITY;
                for (int p = 0; p <= nsel; ++p) {
                    const int blk = (p < nsel) ? (p == 0 ? sel0 : (p == 1 ? sel1 : sel2)) : j;
                    for (int i = 0; i < 4; ++i) {
                        const int kk = i * 64 + lane, kpos = blk * 256 + kk;
                        const u32x4* kr = (const u32x4*)(Km + (size_t)(b * SEQ + kpos) * 512 + h * 64);
                        float s = 0.f;
#pragma unroll
                        for (int c8 = 0; c8 < 8; ++c8) { const u32x4 kv = kr[c8]; const LAS float* qq = sq + c8 * 8;
                            s += qq[0] * bflo(kv.x) + qq[1] * bfhi(kv.x) + qq[2] * bflo(kv.y) + qq[3] * bfhi(kv.y) + qq[4] * bflo(kv.z) + qq[5] * bfhi(kv.z) + qq[6] * bflo(kv.w) + qq[7] * bfhi(kv.w); }
                        const int dist = t - kpos;
                        if (dist < 0) s = -INFINITY; else s += (dist < 128) ? tab[h * 128 + dist] : tab[1024 + h];
                        sp[p * 256 + kk] = s; mx = fmaxf(mx, s);
                    }
                }
                for (int o = 32; o; o >>= 1) mx = fmaxf(mx, __shfl_xor(mx, o));
                float sum = 0.f; const int nk = (nsel + 1) * 256;
                for (int i = lane; i < nk; i += 64) { const float ev = __expf(sp[i] - mx); sp[i] = ev; sum += ev; }
                sum = wave_sum(sum);
                asm volatile("s_waitcnt lgkmcnt(0)" ::: "memory");
                float acc = 0.f;
                for (int p = 0; p <= nsel; ++p) {
                    const int blk = (p < nsel) ? (p == 0 ? sel0 : (p == 1 ? sel1 : sel2)) : j;
                    const bf16_t* vr = Vm + (size_t)(b * SEQ + blk * 256) * 512 + h * 64 + lane;
                    for (int kk = 0; kk < 256; ++kk) acc += sp[p * 256 + kk] * bf2f(vr[(size_t)kk * 512]);
                }
                ya[(size_t)(b * SEQ + t) * 512 + h * 64 + lane] = (bf16_t)f2bf(acc / sum);
                asm volatile("s_waitcnt lgkmcnt(0)" ::: "memory");
            }
        }
    }
    grid.sync();

    {
        for (int it = gw; it < 32 * 16 * 64; it += NGW) {
            const int e = it >> 10, q = it & 1023, kb = q >> 6, nb = q & 63;
            const int dr0 = nb * 32, pn = dr0 >> 8, bj = (dr0 >> 7) & 1, cc = dr0 & 127;
            const float* src = (bj ? w_up : w_gate) + (size_t)e * 1024 * 1024;
            transpose_item(src, 1024, pn * 128 + cc, kb * 64, WguT + (size_t)e * 2048 * 1024, 1024, dr0, scr, lane, 32);
        }
        __syncthreads();
        { pg8::DenseOrder S; S.init(TT, 1024, G, bx, ya, 512, WpaT, 512); EpiMix<0> E{GT, MIX};
          pg8::gemm_phase<EpiMix<0>, pg8::DenseOrder, false>(lds, 512, 512, 8, S, E); }
        asm volatile("s_waitcnt vmcnt(0)" ::: "memory"); __syncthreads();
        { pg8::DenseOrder S; S.init(TT, 1024, G, bx, yb, 1024, WpbT, 1024); EpiMix<1> E{GT, MIX};
          pg8::gemm_phase<EpiMix<1>, pg8::DenseOrder, false>(lds, 1024, 1024, 16, S, E); }
    }
    grid.sync();

    {
        pg8::DenseOrder S; S.init(TT, 1024, G, bx, MIX, 1024, WoutT, 1024); EpiX1 E{x, mod + 2048, out};
        pg8::gemm_phase<EpiX1, pg8::DenseOrder, false>(lds, 1024, 1024, 16, S, E);
    }
    grid.sync();

    {
        LAS float* wr_t = (LAS float*)lds;
        for (int i = tid; i < 32 * 1024; i += NTHR) { const int k = i >> 5, e = i & 31; wr_t[e * 1024 + k] = w_router[i]; }
        __syncthreads();
        for (int m = gw; m < TT; m += NGW) {
            const int b = m >> 13;
            const f32x4* xr = (const f32x4*)(out + (size_t)m * DM) + lane;
            f32x4 v[4]; float s = 0.f;
#pragma unroll
            for (int j = 0; j < 4; ++j) { v[j] = xr[64 * j]; s += (v[j][0] * v[j][0] + v[j][1] * v[j][1]) + (v[j][2] * v[j][2] + v[j][3] * v[j][3]); }
            const float rs = rsqrtf(wave_sum(s) * (1.f / DM) + 1e-6f);
            unsigned long long* o8 = (unsigned long long*)(H2 + (size_t)m * DM) + lane;
#pragma unroll
            for (int j = 0; j < 4; ++j) { const int c = 256 * j + 4 * lane;
                const f32x4 w = *(const f32x4*)(norm_ffn + c); const f32x4 sh = *(const f32x4*)(mod + b * 6144 + 3072 + c), sc = *(const f32x4*)(mod + b * 6144 + 4096 + c);
                v[j] = (v[j] * rs) * w * (sc + 1.f) + sh;
                o8[64 * j] = (unsigned long long)pk2(v[j][0], v[j][1]) | ((unsigned long long)pk2(v[j][2], v[j][3]) << 32); }
            float mylogit = 0.f;
            for (int e = 0; e < 32; ++e) { float a = 0.f;
#pragma unroll
                for (int j = 0; j < 4; ++j) { const f32x4 w = *(const LAS f32x4*)(wr_t + e * 1024 + 256 * j + 4 * lane); a += (v[j][0] * w[0] + v[j][1] * w[1]) + (v[j][2] * w[2] + v[j][3] * w[3]); }
                a = wave_sum(a); if (lane == e) mylogit = a + b_router[e]; }
            float g = lane < 32 ? mylogit : -INFINITY;
            float tv[4]; int ti[4];
#pragma unroll
            for (int k = 0; k < 4; ++k) { float vv = g; int idx = lane;
                for (int off = 32; off; off >>= 1) { const float ov = __shfl_xor(vv, off); const int oi = __shfl_xor(idx, off); if (ov > vv || (ov == vv && oi < idx)) { vv = ov; idx = oi; } }
                tv[k] = vv; ti[k] = idx; if (lane == idx) g = -INFINITY; }
            if (lane < 4) {
                const float e1 = __expf(tv[1] - tv[0]), e2 = __expf(tv[2] - tv[0]), e3 = __expf(tv[3] - tv[0]); const float inv = 1.f / (1.f + e1 + e2 + e3);
                const float wk = (lane == 0 ? 1.f : (lane == 1 ? e1 : (lane == 2 ? e2 : e3))) * inv;
                const int ek = lane == 0 ? ti[0] : (lane == 1 ? ti[1] : (lane == 2 ? ti[2] : ti[3]));
                topw[m * 4 + lane] = wk;
                const unsigned pos = atomicAdd(&ctl[CW_CNT + ek], 1u);
                list[(size_t)ek * TT + pos] = m * 4 + lane;
            }
        }
    }
    grid.sync();

    {
        LAS int* blkE = (LAS int*)(lds + LDS_BLKE); LAS int* blkR = (LAS int*)(lds + LDS_BLKR); LAS int* idxT = (LAS int*)(lds + LDS_IDX); LAS int* misc = (LAS int*)(lds + LDS_MISC);
        if (tid == 0) { int nb = 0;
            for (int e = 0; e < 32; ++e) { const int c = (int)__hip_atomic_load(&ctl[CW_CNT + e], __ATOMIC_RELAXED, __HIP_MEMORY_SCOPE_AGENT); const int k = (c + 255) >> 8;
                for (int q = 0; q < k; ++q) { blkE[nb] = e; blkR[nb] = q * 256; ++nb; } }
            misc[1] = nb; }
        __syncthreads();
        const int nb = misc[1];
        const int cp = vcu;
        pg8::MoeOrder S1{0, nb, 8, G, cp, 1, (const char*)H2, (const char*)WguT, blkE, idxT};
        { pg8::Unit u;
          for (int i = 0; S1.next(i, u); ++i) {
              for (int rr = tid; rr < 256; rr += NTHR) { const int e = u.e; const int r = blkR[u.pm] + rr; const int cnt = (int)__hip_atomic_load(&ctl[CW_CNT + e], __ATOMIC_RELAXED, __HIP_MEMORY_SCOPE_AGENT);
                  const bool ok = r < cnt; const int a = list[(size_t)e * TT + (ok ? r : 0)];
                  idxT[i * 256 + rr] = a >> 2;
                  if (ok && u.pn == 0) dest[a] = u.pm * 256 + rr; }
          } }
        __syncthreads();
        { EpiAct E{b_gate, b_up, ACT};
          pg8::gemm_phase<EpiAct, pg8::MoeOrder, true>(lds, 1024, 1024, 16, S1, E); }
        grid.sync();
        const int rounds = (nb + 63) >> 6, nbA = ((rounds + 1) >> 1) * 64 < nb ? ((rounds + 1) >> 1) * 64 : nb;
        { pg8::MoeOrder S2{0, nbA, 4, G, cp, 0, (const char*)ACT, (const char*)WdT, blkE, idxT}; EpiDown E{b_down, YA, 0};
          pg8::gemm_phase<EpiDown, pg8::MoeOrder, false>(lds, 1024, 1024, 16, S2, E); }
        grid.sync();
        { pg8::MoeOrder S2{nbA, nb, 4, G, cp, 0, (const char*)ACT, (const char*)WdT, blkE, idxT}; EpiDown E{b_down, YBr, nbA};
          pg8::gemm_phase<EpiDown, pg8::MoeOrder, false>(lds, 1024, 1024, 16, S2, E); }
        grid.sync();
        for (int m = gw; m < TT; m += NGW) {
            const int b = m >> 13;
            f32x4* xr = (f32x4*)(out + (size_t)m * DM) + lane;
            f32x4 v[4];
#pragma unroll
            for (int j = 0; j < 4; ++j) v[j] = (f32x4){0.f, 0.f, 0.f, 0.f};
#pragma unroll
            for (int k = 0; k < 4; ++k) { const int sl = dest[m * 4 + k]; const float wk = topw[m * 4 + k];
                const bf16_t* yr = (sl < nbA * 256) ? (YA + (size_t)sl * 1024) : (YBr + (size_t)(sl - nbA * 256) * 1024);
                const u32x2* y2 = (const u32x2*)yr + lane;
#pragma unroll
                for (int j = 0; j < 4; ++j) { const u32x2 p = y2[64 * j]; v[j] += (f32x4){bflo(p.x), bfhi(p.x), bflo(p.y), bfhi(p.y)} * wk; } }
            float s = 0.f;
#pragma unroll
            for (int j = 0; j < 4; ++j) { const int c = 256 * j + 4 * lane; const f32x4 g2 = *(const f32x4*)(mod + b * 6144 + 5120 + c);
                v[j] = xr[64 * j] + g2 * v[j]; s += (v[j][0] * v[j][0] + v[j][1] * v[j][1]) + (v[j][2] * v[j][2] + v[j][3] * v[j][3]); }
            const float rs = rsqrtf(wave_sum(s) * (1.f / DM) + 1e-6f);
#pragma unroll
            for (int j = 0; j < 4; ++j) { const int c = 256 * j + 4 * lane; xr[64 * j] = v[j] * rs * *(const f32x4*)(norm_final + c); }
        }
    }
}

extern "C" void kernel_launch(void* const* d_in, const int* in_sizes, int n_in, void* d_out, int out_size, void* d_ws, size_t ws_size, hipStream_t stream) {
    static int grid = 0;
    if (grid == 0) {
        if (n_in != 23 || out_size != TT * DM || ws_size < WS_NEED) { fprintf(stderr, "kernel_launch: unexpected shapes (n_in %d out %d ws %zu)\n", n_in, out_size, ws_size); grid = -1; return; }
        int dev = 0, cus = 0, per_cu = 0;
        (void)hipGetDevice(&dev); (void)hipDeviceGetAttribute(&cus, hipDeviceAttributeMultiprocessorCount, dev);
        if (hipFuncSetAttribute((const void*)mega_fwd, hipFuncAttributeMaxDynamicSharedMemorySize, LDS_BYTES) != hipSuccess) { fprintf(stderr, "kernel_launch: hipFuncSetAttribute failed\n"); grid = -1; return; }
        if (hipOccupancyMaxActiveBlocksPerMultiprocessor(&per_cu, (const void*)mega_fwd, NTHR, LDS_BYTES) != hipSuccess || per_cu < 1) { fprintf(stderr, "kernel_launch: occupancy query failed (%d)\n", per_cu); (void)hipGetLastError(); grid = -1; return; }
        grid = cus;
    }
    if (grid < 0) return;
    (void)hipMemsetAsync((char*)d_ws + WS_CTL, 0, 65536, stream);
    Args a{};
    for (int i = 0; i < 23; ++i) a.in[i] = (const float*)d_in[i];
    a.out = (float*)d_out; a.ws = (unsigned char*)d_ws;
    void* kargs[] = {&a};
    hipError_t e = hipLaunchCooperativeKernel((const void*)mega_fwd, dim3(grid), dim3(NTHR), kargs, LDS_BYTES, stream);
    if (e != hipSuccess) fprintf(stderr, "cooperative launch failed: %s (grid %d)\n", hipGetErrorString(e), grid);
}
```

```cpp
#include <hip/hip_runtime.h>
#include <hip/hip_cooperative_groups.h>
#include <cstdio>
#include <cstdint>
#include <math.h>
namespace cg = cooperative_groups;

#define LAS __attribute__((address_space(3)))
typedef unsigned short bf16_t;
typedef short bf16x8 __attribute__((ext_vector_type(8)));
typedef float f32x4 __attribute__((ext_vector_type(4)));
typedef unsigned u32x4 __attribute__((ext_vector_type(4)));
typedef unsigned u32x2 __attribute__((ext_vector_type(2)));
typedef float f32x16 __attribute__((ext_vector_type(16)));
typedef float f32x2_t __attribute__((ext_vector_type(2)));
typedef __bf16 bf16x2_t __attribute__((ext_vector_type(2)));
__device__ __forceinline__ unsigned cvtpk(float lo, float hi) { f32x2_t v = {lo, hi}; bf16x2_t b = __builtin_convertvector(v, bf16x2_t); return __builtin_bit_cast(unsigned, b); }
__device__ __forceinline__ int crow(int reg, int h) { return (reg & 3) + 8 * (reg >> 2) + 4 * h; }

constexpr int NB = 4, SEQ = 8192, DM = 1024, TT = NB * SEQ, DIN = 6672;
constexpr int NPROJ = 6912;
constexpr int NEXP = 32;
constexpr int NWAVES = 8, NTHR = 512;
constexpr size_t MiB = (size_t)1 << 20;

constexpr size_t KiB = 1024;
constexpr size_t WS_CTL = 0;
constexpr size_t WS_MODP = 128 * KiB;
constexpr size_t WS_MOD = 896 * KiB;
constexpr size_t WS_TAB = 992 * KiB;
constexpr size_t WS_KMEAN = 1 * MiB;
constexpr size_t WS_GK = 1 * MiB + 256 * KiB;
constexpr size_t WS_TOPW = 3 * MiB + 256 * KiB;
constexpr size_t WS_DEST = 3 * MiB + 768 * KiB;
constexpr size_t WS_LIST = 4 * MiB + 256 * KiB;
constexpr size_t WS_WIN = 8 * MiB + 256 * KiB;
constexpr size_t WS_WPA = 21 * MiB + 768 * KiB;
constexpr size_t WS_WPB = 22 * MiB + 768 * KiB;
constexpr size_t WS_WOUT = 24 * MiB + 768 * KiB;
constexpr size_t WS_BIG = 28 * MiB;
constexpr size_t WS_GT = WS_BIG;
constexpr size_t WS_R = WS_BIG + 128 * MiB;
constexpr size_t WS_MIX = WS_R;
constexpr size_t WS_VB = WS_BIG + 192 * MiB;
constexpr size_t WS_QB = WS_BIG + 256 * MiB;
constexpr size_t WS_KB = WS_BIG + 288 * MiB;
constexpr size_t WS_QM = WS_BIG + 320 * MiB;
constexpr size_t WS_KM = WS_BIG + 352 * MiB;
constexpr size_t WS_VM = WS_BIG + 384 * MiB;
constexpr size_t WS_XN = WS_BIG + 416 * MiB;
constexpr size_t WS_WD = 508 * MiB;
constexpr size_t WS_ACT = WS_BIG;
constexpr size_t WS_WGU = 304 * MiB;
constexpr size_t WS_H2 = 432 * MiB;
constexpr size_t WS_YA = 304 * MiB;
constexpr size_t WS_VT = WS_XN;
constexpr size_t WS_YAW = WS_XN + 32 * MiB;
constexpr size_t WS_YBW = 508 * MiB;
constexpr size_t WS_ML = WS_VM;
constexpr size_t WS_LST = WS_VM + 8 * MiB;
constexpr size_t WS_NEED = 572 * MiB;
static_assert(WS_WOUT + 2 * MiB <= WS_BIG && WS_XN + 64 * MiB <= WS_WD && WS_WD + 64 * MiB <= WS_NEED, "ws map");
static_assert(WS_ACT + 272 * MiB <= WS_WGU && WS_WGU + 128 * MiB <= WS_H2 && WS_H2 + 64 * MiB <= WS_WD && WS_YA + 160 * MiB <= WS_WD, "moe map");

constexpr int CW_CNT = 0;
constexpr int CW_QCTR = 64;
constexpr int CW_ERR = 128;
constexpr int CW_BAR = 4096;
constexpr int CW_LCNT = 1024;
constexpr int MB_CH = 512;
constexpr int LST_STRIDE = 126976;

constexpr int RING_BYTES = 131072;
constexpr int LDS_IDX = RING_BYTES;
constexpr int LDS_BLKE = LDS_IDX + 17408;
constexpr int LDS_BLKR = LDS_BLKE + 2176;
constexpr int LDS_MISC = LDS_BLKR + 2176;
constexpr int LDS_BYTES = LDS_MISC + 256;
static_assert(LDS_BYTES <= 163840, "LDS");

__device__ __forceinline__ unsigned f2bf(float f) { unsigned u = __builtin_bit_cast(unsigned, f); return (u + 0x7fffu + ((u >> 16) & 1u)) >> 16; }
__device__ __forceinline__ unsigned pk2(float lo, float hi) { return f2bf(lo) | (f2bf(hi) << 16); }
__device__ __forceinline__ float bf2f(unsigned short b) { return __builtin_bit_cast(float, (unsigned)b << 16); }
__device__ __forceinline__ float bflo(unsigned w) { return __builtin_bit_cast(float, w << 16); }
__device__ __forceinline__ float bfhi(unsigned w) { return __builtin_bit_cast(float, w & 0xffff0000u); }
__device__ __forceinline__ float sigm(float x) { return 1.f / (1.f + __expf(-x)); }
__device__ __forceinline__ float wave_sum(float v) {
#pragma unroll
    for (int o = 1; o < 64; o <<= 1) v += __shfl_xor(v, o);
    return v;
}

namespace pg8 {
constexpr int BM = 256, BK = 64, HALF = 128, HTB = HALF * BK * 2, NXCD = 8, WGM = 8;
__host__ __device__ __forceinline__ int lds_byte(int r, int c) { const int st = (r >> 4) * 2 + (c >> 5), rr = r & 15, cc = c & 31, ob = rr * 64 + cc * 2; return st * 1024 + (ob ^ (((ob >> 9) & 1) << 5)); }
__host__ __device__ __forceinline__ void stage_rc(int b, int& R, int& C) { const int st = b / 1024, sb = b % 1024, swz = sb ^ (((sb >> 9) & 1) << 5); R = (st >> 1) * 16 + swz / 64; C = (st & 1) * 32 + (swz % 64) / 2; }
__host__ __device__ __forceinline__ int perm32(int rho) { const int n = rho >> 4, i = rho & 15; return 8 * (i >> 2) + 4 * n + (i & 3); }

struct Unit { int pm, pn, e; const char* A; const char* B; };

struct DenseOrder {
    int nM, nN, nwg, G, c; const char* A0; const char* B0; size_t astep, bstep;
    __device__ void init(int M, int N, int G_, int c_, const void* A, int lda, const void* B, int ldb) { nM = M / BM; nN = N / BM; nwg = nM * nN; G = G_; c = c_; A0 = (const char*)A; B0 = (const char*)B; astep = (size_t)BM * lda * 2; bstep = (size_t)BM * ldb * 2; }
    __device__ bool next(int i, Unit& u) const {
        const long L = (long)i * G + c; if (L >= nwg) return false;
        int wgid = (int)L; { const int q = nwg / NXCD, r = nwg % NXCD, xcd = wgid % NXCD, off = wgid / NXCD; wgid = (xcd < r ? xcd * (q + 1) : r * (q + 1) + (xcd - r) * q) + off; }
        const int nig = WGM * nN, gid = wgid / nig, fm = gid * WGM, gsz = (nM - fm) < WGM ? (nM - fm) : WGM;
        u.pm = fm + ((wgid % nig) % gsz); u.pn = (wgid % nig) / gsz; u.e = 0;
        u.A = A0 + (size_t)u.pm * astep; u.B = B0 + (size_t)u.pn * bstep; return true;
    }
    __device__ __forceinline__ int gidx(int, int) const { return 0; }
};

struct MoeOrder {
    int lo, hi, ncol, G, cp, gather; const char* A0; const char* B0; const LAS int* blkE; const LAS int* idx;
    __device__ bool next(int i, Unit& u) const {
        const long L = (long)i * G + cp; const int b = lo + (int)(L / ncol); if (b >= hi) return false;
        u.pm = b; u.pn = (int)(L % ncol); u.e = blkE[b];
        u.A = gather ? A0 : A0 + (size_t)b * (256 * 1024 * 2); u.B = B0 + ((size_t)u.e * ncol + u.pn) * (size_t)(256 * 1024 * 2); return true;
    }
    __device__ __forceinline__ int gidx(int ui, int row) const { return idx[ui * 256 + row]; }
};

#define PG8_WAIT_V(n) asm volatile("s_waitcnt vmcnt(" #n ")" ::: "memory")
#define PG8_WAIT_L(n) asm volatile("s_waitcnt lgkmcnt(" #n ")" ::: "memory")
#define PG8_BAR __builtin_amdgcn_s_barrier()
#define PG8_SCHED __builtin_amdgcn_sched_barrier(0)

template <class Epi, class Sched, bool GATHER>
__device__ __forceinline__ void gemm_phase(LAS unsigned char* lds, const int lda, const int ldb, const int nt, const Sched& S, const Epi& E) {
    const int tid = threadIdx.x, wid = __builtin_amdgcn_readfirstlane(tid >> 6), lane = tid & 63, wr = wid >> 2, wc = wid & 3, fr = lane & 15, fq = lane >> 4;
    unsigned voffA[2], voffA1[2], voffB[2];
#pragma unroll
    for (int i = 0; i < 2; ++i) { int R, C; stage_rc(tid * 16 + i * 8192, R, C); const int Rb = Epi::PERM ? ((R & ~31) + perm32(R & 31)) : R;
        voffA[i] = (unsigned)(R * lda + C) * 2u; voffA1[i] = voffA[i]; voffB[i] = (unsigned)(Rb * ldb + C) * 2u; }
    const size_t kstep = (size_t)(BK * 2);
    const size_t hstepA = GATHER ? 0 : (size_t)HALF * lda * 2, hstepB = (size_t)HALF * ldb * 2;
    const unsigned ldsw = (unsigned)wid * 1024u;
    const int aoff = lds_byte(wr * 64 + fr, fq * 8), boff = lds_byte(wc * 32 + fr, fq * 8);
#define PG8_SA(b, h) (((b) * 2 + (h)) * HTB)
#define PG8_SB(b, h) ((4 + (b) * 2 + (h)) * HTB)
#define PG8_STAGE(bufoff, gbase, voff) do { _Pragma("unroll") for (int _i = 0; _i < 2; ++_i) \
        __builtin_amdgcn_global_load_lds((const unsigned*)((const char*)(gbase) + (voff)[_i]), (LAS unsigned*)(lds + (bufoff) + ldsw + _i * 8192), 16, 0, 0); } while (0)
#define PG8_LDA(dst, b, h) do { _Pragma("unroll") for (int m = 0; m < 4; ++m) _Pragma("unroll") for (int k = 0; k < 2; ++k) dst[m][k] = *(const LAS bf16x8*)(lds + PG8_SA(b, h) + aoff + m * 2048 + k * 1024); } while (0)
#define PG8_LDB(dst, b, h) do { _Pragma("unroll") for (int n = 0; n < 2; ++n) _Pragma("unroll") for (int k = 0; k < 2; ++k) dst[n][k] = *(const LAS bf16x8*)(lds + PG8_SB(b, h) + boff + n * 2048 + k * 1024); } while (0)
#define PG8_MMA(ai, bj, At, Bt) do { __builtin_amdgcn_s_setprio(1); _Pragma("unroll") for (int m = 0; m < 4; ++m) _Pragma("unroll") for (int n = 0; n < 2; ++n) _Pragma("unroll") for (int k = 0; k < 2; ++k) \
        acc[ai][bj][m][n] = __builtin_amdgcn_mfma_f32_16x16x32_bf16(Bt[n][k], At[m][k], acc[ai][bj][m][n], 0, 0, 0); __builtin_amdgcn_s_setprio(0); } while (0)
#define PG8_GLOAD(uix) do { if constexpr (GATHER) { _Pragma("unroll") for (int _i = 0; _i < 2; ++_i) { int R_, C_; stage_rc((int)threadIdx.x * 16 + _i * 8192, R_, C_); \
        voffA[_i] = (unsigned)(S.gidx(uix, R_) * lda + C_) * 2u; voffA1[_i] = (unsigned)(S.gidx(uix, 128 + R_) * lda + C_) * 2u; } } } while (0)
    Unit cur, nxt; int ui = 0;
    if (!S.next(0, cur)) return;
    f32x4 acc[2][2][4][2];
#pragma unroll
    for (int a = 0; a < 2; ++a)
#pragma unroll
        for (int b = 0; b < 2; ++b)
#pragma unroll
            for (int m = 0; m < 4; ++m)
#pragma unroll
                for (int n = 0; n < 2; ++n) acc[a][b][m][n] = (f32x4){0.f, 0.f, 0.f, 0.f};
    bf16x8 At[4][2], B0[2][2], B1[2][2];
    const char* cA = cur.A; const char* cB = cur.B;
    PG8_GLOAD(0);
    PG8_STAGE(PG8_SB(0, 0), cB, voffB); PG8_STAGE(PG8_SB(0, 1), cB + hstepB, voffB); PG8_STAGE(PG8_SA(0, 0), cA, voffA); PG8_STAGE(PG8_SA(0, 1), cA + hstepA, voffA1);
    if (wr == 1) PG8_BAR;
    PG8_WAIT_V(2); PG8_BAR;
    PG8_STAGE(PG8_SB(1, 0), cB + kstep, voffB); PG8_STAGE(PG8_SA(1, 0), cA + kstep, voffA); PG8_STAGE(PG8_SB(1, 1), cB + hstepB + kstep, voffB);
    PG8_WAIT_V(6); PG8_BAR;
    for (;;) {
        const bool has_next = S.next(ui + 1, nxt);
        const char* nA = has_next ? nxt.A : cA; const char* nB = has_next ? nxt.B : cB;
        for (int t = 0; t < nt; t += 2) {
            const bool last = (t == nt - 2);
            const char* a1 = cA + (size_t)(t + 1) * kstep;
            const char* a2 = last ? nA : cA + (size_t)(t + 2) * kstep; const char* b2 = last ? nB : cB + (size_t)(t + 2) * kstep;
            const char* a3 = a2 + kstep; const char* b3 = b2 + kstep;
            PG8_LDB(B0, 0, 0); PG8_LDB(B1, 0, 1); PG8_SCHED; PG8_LDA(At, 0, 0); PG8_STAGE(PG8_SA(1, 1), a1 + hstepA, voffA1);
            if (GATHER && last && has_next) { PG8_GLOAD(ui + 1); }
            PG8_WAIT_V(8); PG8_WAIT_L(0); PG8_BAR; PG8_MMA(0, 0, At, B0); PG8_MMA(0, 1, At, B1); PG8_BAR; PG8_SCHED;
            PG8_LDA(At, 0, 1); PG8_STAGE(PG8_SB(0, 0), b2, voffB); PG8_STAGE(PG8_SB(0, 1), b2 + hstepB, voffB); PG8_STAGE(PG8_SA(0, 0), a2, voffA);
            PG8_WAIT_V(8); PG8_WAIT_L(0); PG8_BAR; PG8_MMA(1, 0, At, B0); PG8_MMA(1, 1, At, B1); PG8_BAR; PG8_SCHED;
            PG8_LDB(B0, 1, 0); PG8_LDB(B1, 1, 1); PG8_SCHED; PG8_LDA(At, 1, 0); PG8_STAGE(PG8_SA(0, 1), a2 + hstepA, voffA1);
            PG8_WAIT_V(8); PG8_WAIT_L(0); PG8_BAR; PG8_MMA(0, 0, At, B0); PG8_MMA(0, 1, At, B1); PG8_BAR; PG8_SCHED;
            PG8_LDA(At, 1, 1); PG8_STAGE(PG8_SB(1, 0), b3, voffB); PG8_STAGE(PG8_SB(1, 1), b3 + hstepB, voffB); PG8_STAGE(PG8_SA(1, 0), a3, voffA);
            PG8_WAIT_V(8); PG8_WAIT_L(0); PG8_BAR; PG8_MMA(1, 0, At, B0); PG8_MMA(1, 1, At, B1); PG8_BAR; PG8_SCHED;
        }
        if (wr == 0) PG8_BAR;
        E(acc, cur, wr, wc, fr, fq);
        if (!has_next) break;
#pragma unroll
        for (int a = 0; a < 2; ++a)
#pragma unroll
            for (int b = 0; b < 2; ++b)
#pragma unroll
                for (int m = 0; m < 4; ++m)
#pragma unroll
                    for (int n = 0; n < 2; ++n) acc[a][b][m][n] = (f32x4){0.f, 0.f, 0.f, 0.f};
        cur = nxt; cA = nA; cB = nB; ++ui;
        if (wr == 1) PG8_BAR;
    }
    PG8_WAIT_V(0);
    PG8_BAR;
#undef PG8_SA
#undef PG8_SB
#undef PG8_STAGE
#undef PG8_LDA
#undef PG8_LDB
#undef PG8_MMA
#undef PG8_GLOAD
}
}

typedef f32x4 Acc[2][2][4][2];
__device__ __forceinline__ u32x4 pack8(f32x4 a, f32x4 b) { u32x4 w; w.x = pk2(a[0], a[1]); w.y = pk2(a[2], a[3]); w.z = pk2(b[0], b[1]); w.w = pk2(b[2], b[3]); return w; }
__device__ __forceinline__ f32x4 silu4(f32x4 v) { return (f32x4){v[0] * sigm(v[0]), v[1] * sigm(v[1]), v[2] * sigm(v[2]), v[3] * sigm(v[3])}; }
__device__ __forceinline__ f32x4 sigm4(f32x4 v) { return (f32x4){sigm(v[0]), sigm(v[1]), sigm(v[2]), sigm(v[3])}; }

struct EpiProj {
    static constexpr bool PERM = true;
    unsigned char* ws;
    __device__ __forceinline__ void operator()(const Acc& acc, const pg8::Unit& u, int wr, int wc, int fr, int fq) const {
        const int pn = u.pn; size_t boff; int ldc, ct, fn = 0; float sc = 1.f;
        if (pn < 2) { boff = WS_QM; ldc = 512; ct = pn; sc = 0.125f; }
        else if (pn < 4) { boff = WS_KM; ldc = 512; ct = pn - 2; }
        else if (pn < 6) { boff = WS_VM; ldc = 512; ct = pn - 4; }
        else if (pn < 8) { boff = WS_QB; ldc = 512; ct = pn - 6; sc = 0.08838834764831845f; }
        else if (pn < 10) { boff = WS_KB; ldc = 512; ct = pn - 8; }
        else if (pn < 14) { boff = WS_VB; ldc = 1024; ct = pn - 10; }
        else if (pn < 18) { boff = WS_R; ldc = 1024; ct = pn - 14; fn = 1; }
        else if (pn < 26) { boff = WS_GT; ldc = 2048; ct = pn - 18; fn = 2; }
        else {
            if (wc == 0 && fq < 2) {
                float* gk = (float*)(ws + WS_GK);
#pragma unroll
                for (int ai = 0; ai < 2; ++ai)
#pragma unroll
                    for (int m = 0; m < 4; ++m) { const int r = u.pm * 256 + ai * 128 + wr * 64 + m * 16 + fr;
                        *(f32x4*)(gk + (size_t)r * 16 + 8 * fq) = acc[ai][0][m][0]; *(f32x4*)(gk + (size_t)r * 16 + 8 * fq + 4) = acc[ai][0][m][1]; }
            }
            return;
        }
        bf16_t* base = (bf16_t*)(ws + boff);
        const int col0 = ct * 256 + wc * 32 + 8 * fq;
#pragma unroll
        for (int ai = 0; ai < 2; ++ai)
#pragma unroll
            for (int m = 0; m < 4; ++m) { bf16_t* rowp = base + (size_t)(u.pm * 256 + ai * 128 + wr * 64 + m * 16 + fr) * ldc + col0;
#pragma unroll
                for (int bj = 0; bj < 2; ++bj) { f32x4 v0 = acc[ai][bj][m][0] * sc, v1 = acc[ai][bj][m][1] * sc;
                    if (fn == 1) { v0 = silu4(v0); v1 = silu4(v1); } else if (fn == 2) { v0 = sigm4(v0); v1 = sigm4(v1); }
                    *(u32x4*)(rowp + bj * 128) = pack8(v0, v1); } }
    }
};

template <int MODE> struct EpiMix {
    static constexpr bool PERM = true;
    const bf16_t* gt; bf16_t* mix;
    __device__ __forceinline__ void operator()(const Acc& acc, const pg8::Unit& u, int wr, int wc, int fr, int fq) const {
        const int col0 = u.pn * 256 + wc * 32 + 8 * fq;
#pragma unroll
        for (int ai = 0; ai < 2; ++ai)
#pragma unroll
            for (int m = 0; m < 4; ++m) { const size_t row = (size_t)(u.pm * 256 + ai * 128 + wr * 64 + m * 16 + fr);
#pragma unroll
                for (int bj = 0; bj < 2; ++bj) {
                    const u32x4 g = *(const u32x4*)(gt + row * 2048 + MODE * 1024 + col0 + bj * 128);
                    f32x4 v0 = acc[ai][bj][m][0], v1 = acc[ai][bj][m][1];
                    v0 = (f32x4){v0[0] * bflo(g.x), v0[1] * bfhi(g.x), v0[2] * bflo(g.y), v0[3] * bfhi(g.y)};
                    v1 = (f32x4){v1[0] * bflo(g.z), v1[1] * bfhi(g.z), v1[2] * bflo(g.w), v1[3] * bfhi(g.w)};
                    bf16_t* op = mix + row * 1024 + col0 + bj * 128;
                    if (MODE == 1) { const u32x4 p = *(const u32x4*)op;
                        v0 += (f32x4){bflo(p.x), bfhi(p.x), bflo(p.y), bfhi(p.y)}; v1 += (f32x4){bflo(p.z), bfhi(p.z), bflo(p.w), bfhi(p.w)}; }
                    *(u32x4*)op = pack8(v0, v1); } }
    }
};

struct EpiX1 {
    static constexpr bool PERM = false;
    const float* x; const float* g1; float* x1;
    __device__ __forceinline__ void operator()(const Acc& acc, const pg8::Unit& u, int wr, int wc, int fr, int fq) const {
        const int col0 = u.pn * 256 + wc * 32 + 4 * fq; const int b = u.pm >> 5;
#pragma unroll
        for (int bj = 0; bj < 2; ++bj)
#pragma unroll
            for (int n = 0; n < 2; ++n) { const int c = col0 + bj * 128 + n * 16; const f32x4 gv = *(const f32x4*)(g1 + b * 6144 + c);
#pragma unroll
                for (int ai = 0; ai < 2; ++ai)
#pragma unroll
                    for (int m = 0; m < 4; ++m) { const size_t off = (size_t)(u.pm * 256 + ai * 128 + wr * 64 + m * 16 + fr) * 1024 + c;
                        *(f32x4*)(x1 + off) = *(const f32x4*)(x + off) + gv * acc[ai][bj][m][n]; } }
    }
};

struct EpiAct {
    static constexpr bool PERM = true;
    const float* bg; const float* bu; bf16_t* act;
    __device__ __forceinline__ void operator()(const Acc& acc, const pg8::Unit& u, int wr, int wc, int fr, int fq) const {
        const int col0 = u.pn * 128 + wc * 32 + 8 * fq;
        const f32x4 g0 = *(const f32x4*)(bg + u.e * 1024 + col0), g1 = *(const f32x4*)(bg + u.e * 1024 + col0 + 4);
        const f32x4 u0 = *(const f32x4*)(bu + u.e * 1024 + col0), u1 = *(const f32x4*)(bu + u.e * 1024 + col0 + 4);
#pragma unroll
        for (int ai = 0; ai < 2; ++ai)
#pragma unroll
            for (int m = 0; m < 4; ++m) { const size_t row = (size_t)u.pm * 256 + ai * 128 + wr * 64 + m * 16 + fr;
                f32x4 a0, a1;
#pragma unroll
                for (int j = 0; j < 4; ++j) {
                    float g = fminf(acc[ai][0][m][0][j] + g0[j], 7.f), uu = fminf(fmaxf(acc[ai][1][m][0][j] + u0[j], -7.f), 7.f);
                    a0[j] = g * sigm(1.702f * g) * (uu + 1.f);
                    g = fminf(acc[ai][0][m][1][j] + g1[j], 7.f); uu = fminf(fmaxf(acc[ai][1][m][1][j] + u1[j], -7.f), 7.f);
                    a1[j] = g * sigm(1.702f * g) * (uu + 1.f);
                }
                *(u32x4*)(act + row * 1024 + col0) = pack8(a0, a1); }
    }
};

struct EpiDown {
    static constexpr bool PERM = true;
    const float* bd; bf16_t* y; int blk0;
    __device__ __forceinline__ void operator()(const Acc& acc, const pg8::Unit& u, int wr, int wc, int fr, int fq) const {
        const int col0 = u.pn * 256 + wc * 32 + 8 * fq;
#pragma unroll
        for (int bj = 0; bj < 2; ++bj) { const int c = col0 + bj * 128;
            const f32x4 b0 = *(const f32x4*)(bd + u.e * 1024 + c), b1 = *(const f32x4*)(bd + u.e * 1024 + c + 4);
#pragma unroll
            for (int ai = 0; ai < 2; ++ai)
#pragma unroll
                for (int m = 0; m < 4; ++m) { const size_t row = (size_t)(u.pm - blk0) * 256 + ai * 128 + wr * 64 + m * 16 + fr;
                    *(u32x4*)(y + row * 1024 + c) = pack8(acc[ai][bj][m][0] + b0, acc[ai][bj][m][1] + b1); } }
    }
};

__device__ __forceinline__ int fresh_tid() { int t = threadIdx.x; asm volatile("" : "+v"(t)); return t; }
#define PHASE_IDS const int tid = fresh_tid(); const int lane = tid & 63, wave = __builtin_amdgcn_readfirstlane(tid >> 6); const int gw = vcu * NWAVES + wave; LAS float* scr = (LAS float*)(lds + wave * 16384); (void)lane; (void)gw; (void)scr;

#define XB_TMO      128
#define XB_XCNT(j)  (256  + 64 * (j))
#define XB_XSUB(j)  (1280 + 64 * (j))
#define XB_XGEN(j)  (2304 + 64 * (j))
#define XB_TOP      3328
#define XB_TOPGEN   3392
#define XCD_BAR_WORDS 3456
#define XB_SPIN_CAP (1u << 20)
__device__ __forceinline__ unsigned xb_ld(unsigned* p)              { return __hip_atomic_load(p, __ATOMIC_RELAXED, __HIP_MEMORY_SCOPE_AGENT); }
__device__ __forceinline__ unsigned xb_add(unsigned* p, unsigned v) { return __hip_atomic_fetch_add(p, v, __ATOMIC_RELAXED, __HIP_MEMORY_SCOPE_AGENT); }
__device__ __forceinline__ unsigned xb_xcc_id() { return (unsigned)__builtin_amdgcn_s_getreg((3 << 11) | 20) & 0xFu; }
#define XB_SPIN(cond, bar) do { unsigned _sp = 0; while (cond) { __builtin_amdgcn_s_sleep(1); \
    if ((++_sp & 255u) == 0u) { if (xb_ld(&(bar)[XB_TMO])) break; if (_sp > XB_SPIN_CAP) { atomicAdd(&(bar)[XB_TMO], 1u); break; } } } } while (0)
struct XcdBarrier { unsigned* bar; unsigned x; volatile LAS unsigned* st; };
__device__ __forceinline__ XcdBarrier xcd_barrier_post(unsigned* bar, volatile LAS unsigned* st) {
    XcdBarrier b; b.bar = bar; b.x = xb_xcc_id(); b.st = st;
    if (threadIdx.x == 0) (void)xb_add(&bar[XB_XCNT(b.x)], 1u);
    return b;
}
__device__ __forceinline__ void xcd_barrier_complete(unsigned* bar, unsigned x, unsigned& nloc, unsigned& nx) {
    const unsigned G = gridDim.x * gridDim.y * gridDim.z;
    unsigned sum, cnt, mine, sp = 0u;
    for (;;) {
        sum = 0u; cnt = 0u; mine = 0u;
#pragma unroll
        for (unsigned j = 0; j < 16; ++j) { const unsigned c = xb_ld(&bar[XB_XCNT(j)]); sum += c; cnt += (c > 0u) ? 1u : 0u; mine = (j == x) ? c : mine; }
        if (sum == G) break;
        __builtin_amdgcn_s_sleep(1);
        if ((++sp & 255u) == 0u) { if (xb_ld(&bar[XB_TMO])) break; if (sp > XB_SPIN_CAP) { atomicAdd(&bar[XB_TMO], 1u); break; } }
    }
    nloc = mine > 0u ? mine : 1u; nx = cnt > 0u ? cnt : 1u;
}
__device__ __forceinline__ void xcd_barrier(const XcdBarrier& b) {
    asm volatile("s_waitcnt vmcnt(0)" ::: "memory");
    __syncthreads();
    if (threadIdx.x == 0) {
        unsigned* bar = b.bar;
        __builtin_amdgcn_s_waitcnt(0);
        unsigned nloc = b.st[0], nx = b.st[1];
        if (nloc == 0u) { xcd_barrier_complete(bar, b.x, nloc, nx); b.st[0] = nloc; b.st[1] = nx; }
        const unsigned old = xb_add(&bar[XB_XSUB(b.x)], 1u);
        const unsigned gen = old / nloc;
        if (old + 1u == (gen + 1u) * nloc) {
            __builtin_amdgcn_fence(__ATOMIC_RELEASE, "agent");
            asm volatile("s_waitcnt vmcnt(0)" ::: "memory");
            const unsigned og = xb_add(&bar[XB_TOP], 1u);
            const unsigned tg = og / nx;
            if (og + 1u == (tg + 1u) * nx) xb_add(&bar[XB_TOPGEN], 1u);
            else XB_SPIN(xb_ld(&bar[XB_TOPGEN]) == tg, bar);
            __builtin_amdgcn_fence(__ATOMIC_ACQUIRE, "agent");
            xb_add(&bar[XB_XGEN(b.x)], 1u);
            asm volatile("s_waitcnt vmcnt(0)" ::: "memory");
        } else {
            XB_SPIN(xb_ld(&bar[XB_XGEN(b.x)]) == gen, bar);
            __builtin_amdgcn_fence(__ATOMIC_ACQUIRE, "agent");
            asm volatile("s_waitcnt vmcnt(0)" ::: "memory");
        }
    }
    __syncthreads();
}
struct Args {
    const float* in[23]; float* out; unsigned char* ws;
};

__device__ __forceinline__ void transpose_item(const float* W, int ldw, int sc0, int k0, bf16_t* WT, int K, int dr0, LAS float* scr, int lane, int ncols) {
#pragma unroll 8
    for (int i = 0; i < 32; ++i) { const int kk = 2 * i + (lane >> 5); const int cc = lane & 31;
        scr[kk * 33 + cc] = (cc < ncols) ? W[(size_t)(k0 + kk) * ldw + sc0 + cc] : 0.f; }
    asm volatile("s_waitcnt lgkmcnt(0)" ::: "memory");
    const int c = lane & 7;
#pragma unroll
    for (int j = 0; j < 4; ++j) { const int n = (lane >> 3) + 8 * j; const LAS float* s = scr + (8 * c) * 33 + n;
        u32x4 o; o.x = pk2(s[0 * 33], s[1 * 33]); o.y = pk2(s[2 * 33], s[3 * 33]); o.z = pk2(s[4 * 33], s[5 * 33]); o.w = pk2(s[6 * 33], s[7 * 33]);
        *(u32x4*)(WT + (size_t)(dr0 + n) * K + k0 + 8 * c) = o; }
    asm volatile("s_waitcnt lgkmcnt(0)" ::: "memory");
}

__global__ void __launch_bounds__(NTHR, 2) mega_fwd(Args args) {
    extern __shared__ __attribute__((aligned(16))) unsigned char lds_raw[];
    LAS unsigned char* lds = (LAS unsigned char*)lds_raw;
    cg::grid_group grid = cg::this_grid();
    const int G = gridDim.x, bx = blockIdx.x;
    { volatile LAS unsigned* mz = (volatile LAS unsigned*)(lds + LDS_MISC); if (threadIdx.x < 64) mz[threadIdx.x] = 0u; }
    __syncthreads();
    XcdBarrier xbar = xcd_barrier_post((unsigned*)(args.ws + WS_CTL) + CW_BAR, (volatile LAS unsigned*)(lds + LDS_MISC) + 8);
#define GRID_BAR() xcd_barrier(xbar)
    const int vcu = (G % 8 == 0) ? (bx % 8) * (G / 8) + bx / 8 : bx;
    const int NGW = G * NWAVES;
    unsigned char* ws = args.ws;
    const float* x = args.in[0]; const float* cvec = args.in[1]; const float* rel_bias = args.in[2]; const float* w_ada = args.in[3]; const float* b_ada = args.in[4];
    const float* norm_mix = args.in[5]; const float* w_in = args.in[6]; const float* w_gk_up = args.in[7]; const float* b_gk = args.in[8]; const float* gla_norm = args.in[9];
    const float* w_pa = args.in[10]; const float* w_pb = args.in[11]; const float* w_out = args.in[12]; const float* norm_ffn = args.in[13]; const float* w_router = args.in[14];
    const float* b_router = args.in[15]; const float* w_gate = args.in[16]; const float* b_gate = args.in[17]; const float* w_up = args.in[18]; const float* b_up = args.in[19];
    const float* w_down = args.in[20]; const float* b_down = args.in[21]; const float* norm_final = args.in[22];
    float* out = args.out;
    unsigned* ctl = (unsigned*)(ws + WS_CTL);
    float* modp = (float*)(ws + WS_MODP); float* mod = (float*)(ws + WS_MOD); float* tab = (float*)(ws + WS_TAB); float* kmean = (float*)(ws + WS_KMEAN);
    float* gkl = (float*)(ws + WS_GK); float* topw = (float*)(ws + WS_TOPW); int* dest = (int*)(ws + WS_DEST); int* list = (int*)(ws + WS_LIST);
    bf16_t* WinT = (bf16_t*)(ws + WS_WIN); bf16_t* WpaT = (bf16_t*)(ws + WS_WPA); bf16_t* WpbT = (bf16_t*)(ws + WS_WPB); bf16_t* WoutT = (bf16_t*)(ws + WS_WOUT);
    bf16_t* WdT = (bf16_t*)(ws + WS_WD); bf16_t* WguT = (bf16_t*)(ws + WS_WGU);
    bf16_t* XN = (bf16_t*)(ws + WS_XN); bf16_t* Qm = (bf16_t*)(ws + WS_QM); bf16_t* Km = (bf16_t*)(ws + WS_KM); bf16_t* Vm = (bf16_t*)(ws + WS_VM);
    bf16_t* QBb = (bf16_t*)(ws + WS_QB); bf16_t* KBb = (bf16_t*)(ws + WS_KB); bf16_t* VBb = (bf16_t*)(ws + WS_VB); bf16_t* Rb = (bf16_t*)(ws + WS_R); bf16_t* GT = (bf16_t*)(ws + WS_GT);
    bf16_t* MIX = (bf16_t*)(ws + WS_MIX); bf16_t* H2 = (bf16_t*)(ws + WS_H2); bf16_t* ACT = (bf16_t*)(ws + WS_ACT); bf16_t* YA = (bf16_t*)(ws + WS_YA); bf16_t* YBr = (bf16_t*)(ws + WS_ACT);
    bf16_t* ya = (bf16_t*)(ws + WS_YAW);
    bf16_t* yb = (bf16_t*)(ws + WS_YBW);
    bf16_t* VT = (bf16_t*)(ws + WS_VT); bf16_t* PO = (bf16_t*)out; float* ML = (float*)(ws + WS_ML); unsigned short* LST = (unsigned short*)(ws + WS_LST);

    {
        PHASE_IDS
        for (int it = gw; it < 96 * 8; it += NGW) {
            const int cgp = it % 96, kc = it / 96; const int col = cgp * 64 + lane;
            float a0 = 0.f, a1 = 0.f, a2 = 0.f, a3 = 0.f;
            for (int k = kc * 128; k < kc * 128 + 128; ++k) {
                const float w = w_ada[(size_t)k * 6144 + col];
                const float c0 = cvec[k], c1 = cvec[1024 + k], c2 = cvec[2048 + k], c3 = cvec[3072 + k];
                a0 += c0 * sigm(c0) * w; a1 += c1 * sigm(c1) * w; a2 += c2 * sigm(c2) * w; a3 += c3 * sigm(c3) * w;
            }
            float* mp = modp + (size_t)kc * (4 * 6144) + col;
            mp[0] = a0; mp[6144] = a1; mp[2 * 6144] = a2; mp[3 * 6144] = a3;
        }
        if (gw == NGW - 1) {
            for (int i = lane; i < 8 * 128; i += 64) { const int h = i >> 7, n = i & 127; int bkt;
                if (n < 16) bkt = n; else { const int l = 16 + (int)(logf((float)n / 16.f) / logf(8.f) * 16.f); bkt = l < 31 ? l : 31; }
                tab[i] = rel_bias[bkt * 8 + h]; }
            if (lane < 8) tab[1024 + lane] = rel_bias[31 * 8 + lane];
        }
        constexpr int I_IN = 16 * 208, I_GK = 16, I_PA = 8 * 32, I_PB = 16 * 32, I_OUT = 16 * 32, I_WD = 32 * 16 * 32;
        constexpr int NIT = I_IN + I_GK + I_PA + I_PB + I_OUT; (void)I_WD;
        for (int it = gw; it < NIT; it += NGW) {
            int r = it;
            if (r < I_IN) { const int kb = r / 208, nb = r % 208; const int dr0 = nb * 32; const int sc0 = dr0 < 3584 ? dr0 : dr0 + 16;
                transpose_item(w_in, DIN, sc0, kb * 64, WinT, 1024, dr0, scr, lane, 32); continue; } r -= I_IN;
            if (r < I_GK) { transpose_item(w_in, DIN, 3584, r * 64, WinT, 1024, 6656, scr, lane, 16); continue; } r -= I_GK;
            if (r < I_PA) { const int kb = r / 32, nb = r % 32; transpose_item(w_pa, 1024, nb * 32, kb * 64, WpaT, 512, nb * 32, scr, lane, 32); continue; } r -= I_PA;
            if (r < I_PB) { const int kb = r / 32, nb = r % 32; transpose_item(w_pb, 1024, nb * 32, kb * 64, WpbT, 1024, nb * 32, scr, lane, 32); continue; } r -= I_PB;
            { const int kb = r / 32, nb = r % 32; transpose_item(w_out, 1024, nb * 32, kb * 64, WoutT, 1024, nb * 32, scr, lane, 32); }
        }
        for (int i = gw * 64 + lane; i < 224 * 128; i += NGW * 64) *(u32x4*)(WinT + (size_t)6688 * 1024 + (size_t)i * 8) = (u32x4){0u, 0u, 0u, 0u};
    }
    grid.sync();

    {
        PHASE_IDS
        LAS float* smod = (LAS float*)lds;
        for (int i = tid; i < 4 * 2048; i += NTHR) { const int b = i >> 11, c = i & 2047; float s = b_ada[c];
#pragma unroll
            for (int kc = 0; kc < 8; ++kc) s += modp[(size_t)kc * (4 * 6144) + b * 6144 + c];
            smod[i] = s; }
        for (int i = bx * NTHR + tid; i < 4 * 6144; i += G * NTHR) { const int c = i % 6144; float s = b_ada[c];
#pragma unroll
            for (int kc = 0; kc < 8; ++kc) s += modp[(size_t)kc * (4 * 6144) + i];
            mod[i] = s; }
        __syncthreads();
        for (int m = gw; m < TT; m += NGW) {
            const int b = m >> 13;
            const f32x4* xr = (const f32x4*)(x + (size_t)m * DM) + lane;
            f32x4 v[4]; float s = 0.f;
#pragma unroll
            for (int j = 0; j < 4; ++j) { v[j] = xr[64 * j]; s += (v[j][0] * v[j][0] + v[j][1] * v[j][1]) + (v[j][2] * v[j][2] + v[j][3] * v[j][3]); }
            const float rs = rsqrtf(wave_sum(s) * (1.f / DM) + 1e-6f);
            unsigned long long* o8 = (unsigned long long*)(XN + (size_t)m * DM) + lane;
#pragma unroll
            for (int j = 0; j < 4; ++j) { const int c = 256 * j + 4 * lane;
                const f32x4 w = *(const f32x4*)(norm_mix + c); const f32x4 sh = *(const LAS f32x4*)(smod + b * 2048 + c), sc = *(const LAS f32x4*)(smod + b * 2048 + 1024 + c);
                const f32x4 h = (v[j] * rs) * w * (sc + 1.f) + sh;
                o8[64 * j] = (unsigned long long)pk2(h[0], h[1]) | ((unsigned long long)pk2(h[2], h[3]) << 32); }
        }
    }
    GRID_BAR();

    {
        pg8::DenseOrder S; S.init(TT, NPROJ, G, bx, XN, 1024, WinT, 1024);
        EpiProj E{ws};
        pg8::gemm_phase<EpiProj, pg8::DenseOrder, false>(lds, 1024, 1024, 16, S, E);
    }
    GRID_BAR();

    {
    PHASE_IDS
    for (int it = gw; it < 32 * 32; it += NGW) {
        const int bh = it >> 5, n = it & 31, b = bh >> 3, h = bh & 7;
        const bf16_t* kp = Km + (size_t)(b * SEQ + n * 256) * 512 + h * 64 + lane;
        float s = 0.f;
        for (int i = 0; i < 256; ++i) s += bf2f(kp[(size_t)i * 512]);
        kmean[(size_t)it * 64 + lane] = s * (1.f / 256.f);
    }
    {
        LAS unsigned short* tl = (LAS unsigned short*)(lds + wave * 16384);
        for (int it = gw; it < 32 * 128; it += NGW) {
            const int bh = it >> 7, tt = it & 127, b = bh >> 3, h = bh & 7;
            const u32x4* vr = (const u32x4*)(Vm + (size_t)(b * SEQ + tt * 64 + lane) * 512 + h * 64);
#pragma unroll
            for (int c8 = 0; c8 < 8; ++c8) { const u32x4 v = vr[c8];
                tl[(c8 * 8 + 0) * 72 + lane] = (unsigned short)(v.x & 0xffff); tl[(c8 * 8 + 1) * 72 + lane] = (unsigned short)(v.x >> 16);
                tl[(c8 * 8 + 2) * 72 + lane] = (unsigned short)(v.y & 0xffff); tl[(c8 * 8 + 3) * 72 + lane] = (unsigned short)(v.y >> 16);
                tl[(c8 * 8 + 4) * 72 + lane] = (unsigned short)(v.z & 0xffff); tl[(c8 * 8 + 5) * 72 + lane] = (unsigned short)(v.z >> 16);
                tl[(c8 * 8 + 6) * 72 + lane] = (unsigned short)(v.w & 0xffff); tl[(c8 * 8 + 7) * 72 + lane] = (unsigned short)(v.w >> 16); }
            asm volatile("s_waitcnt lgkmcnt(0)" ::: "memory");
            u32x4* dst = (u32x4*)(VT + ((size_t)bh * 64 + lane) * 8192 + tt * 64);
#pragma unroll
            for (int c8 = 0; c8 < 8; ++c8) dst[c8] = *(const LAS u32x4*)(tl + lane * 72 + c8 * 8);
            asm volatile("s_waitcnt lgkmcnt(0)" ::: "memory");
        }
    }
    }
    GRID_BAR();

    {
        PHASE_IDS
        LAS float* kmT = (LAS float*)lds;
        LAS float* sq = (LAS float*)(lds + 8192) + wave * 128;
        const int hl = lane >> 5, nl = lane & 31;
        for (int wgi = vcu; wgi < 256; wgi += G) {
            const int bh = wgi >> 3, tq0 = (wgi & 7) * 1024, b = bh >> 3, h = bh & 7;
            __syncthreads();
            for (int i = tid; i < 2048; i += NTHR) { const int n = i >> 6, d = i & 63; kmT[d * 32 + n] = kmean[(size_t)bh * 2048 + i]; }
            __syncthreads();
            for (int pq = wave; pq < 512; pq += NWAVES) {
                const int t = tq0 + pq * 2 + hl, j = t >> 8;
                if (tq0 + pq * 2 < 256) continue;
                const unsigned qw = *(const unsigned*)(Qm + (size_t)(b * SEQ + t) * 512 + h * 64 + nl * 2);
                sq[hl * 64 + nl * 2] = bflo(qw); sq[hl * 64 + nl * 2 + 1] = bfhi(qw);
                asm volatile("s_waitcnt lgkmcnt(0)" ::: "memory");
                float s = 0.f;
#pragma unroll 16
                for (int d = 0; d < 64; ++d) s += sq[hl * 64 + d] * kmT[d * 32 + nl];
                float g = nl < j ? s : -INFINITY;
                const int nsel = j < 3 ? j : 3; int mysel = 0;
#pragma unroll
                for (int i = 0; i < 3; ++i) { float v = g; int idx = nl;
                    for (int off = 16; off; off >>= 1) { const float ov = __shfl_xor(v, off); const int oi = __shfl_xor(idx, off); if (ov > v || (ov == v && oi < idx)) { v = ov; idx = oi; } }
                    if (nl == i) mysel = idx; if (nl == idx) g = -INFINITY; }
                if (nl < nsel) { const int n = mysel; const unsigned pos = atomicAdd(&ctl[CW_LCNT + bh * 32 + n], 1u);
                    LST[(size_t)bh * LST_STRIDE + 256 * (31 * n - (n * (n - 1)) / 2) + pos] = (unsigned short)((t << 2) | nl); }
                asm volatile("s_waitcnt lgkmcnt(0)" ::: "memory");
            }
        }
    }
    GRID_BAR();

    if (bx < 64) {
        PHASE_IDS
        const int b = bx >> 4, h = (bx >> 2) & 3, es = bx & 3;
        LAS unsigned char* Qg = lds;
        LAS unsigned char* Kg = lds + 17408;
        LAS unsigned char* KeT = lds + 34816;
        LAS unsigned char* VTl = lds + 53248;
        LAS unsigned char* STl = lds + 62464;
        LAS float* decl = (LAS float*)(lds + 79872);
        LAS float* gks = (LAS float*)(lds + 80384);
        LAS float* cpart = (LAS float*)(lds + 84480);
        const int dp = tid & 63, c8 = wave, d0 = 2 * dp;
        const int r = lane & 31, hf = lane >> 5;
        float w0[16], w1[16];
#pragma unroll
        for (int q = 0; q < 16; ++q) { w0[q] = w_gk_up[q * 512 + h * 128 + d0]; w1[q] = w_gk_up[q * 512 + h * 128 + d0 + 1]; }
        const float bias0 = b_gk[h * 128 + d0], bias1 = b_gk[h * 128 + d0 + 1];
        for (int i = tid; i < 17408 / 4; i += NTHR) ((LAS unsigned*)STl)[i] = 0u;
        f32x16 sacc;
#pragma unroll
        for (int i = 0; i < 16; ++i) sacc[i] = 0.f;
        const int sdt = wave >> 1, set_ = wave & 1;
        const size_t tok0 = (size_t)b * SEQ;
        unsigned qr[8], kr[8]; unsigned short vr[8]; float gr[2];
#define GLA_LOAD(n_) do { const size_t t0_ = tok0 + (size_t)(n_) * 64; \
            _Pragma("unroll") for (int i = 0; i < 8; ++i) { const size_t row_ = t0_ + c8 * 8 + i; \
                qr[i] = *(const unsigned*)(QBb + row_ * 512 + h * 128 + d0); kr[i] = *(const unsigned*)(KBb + row_ * 512 + h * 128 + d0); \
                vr[i] = VBb[row_ * 1024 + h * 256 + es * 64 + dp]; } \
            gr[0] = gkl[t0_ * 16 + tid * 2]; gr[1] = gkl[t0_ * 16 + tid * 2 + 1]; } while (0)
        GLA_LOAD(0);
        for (int n = 0; n < SEQ / 64; ++n) {
            gks[tid * 2] = gr[0]; gks[tid * 2 + 1] = gr[1];
            { u32x4 pv; pv.x = (unsigned)vr[0] | ((unsigned)vr[1] << 16); pv.y = (unsigned)vr[2] | ((unsigned)vr[3] << 16); pv.z = (unsigned)vr[4] | ((unsigned)vr[5] << 16); pv.w = (unsigned)vr[6] | ((unsigned)vr[7] << 16);
              *(LAS u32x4*)(VTl + dp * 144 + c8 * 16) = pv; }
            __syncthreads();
            float bc0[8], bc1[8]; float run0 = 0.f, run1 = 0.f;
#pragma unroll
            for (int i = 0; i < 8; ++i) { const LAS f32x4* gp = (const LAS f32x4*)(gks + (c8 * 8 + i) * 16); float s0 = bias0, s1 = bias1;
#pragma unroll
                for (int q4 = 0; q4 < 4; ++q4) { const f32x4 g4 = gp[q4];
                    s0 += g4[0] * w0[4 * q4] + g4[1] * w0[4 * q4 + 1] + g4[2] * w0[4 * q4 + 2] + g4[3] * w0[4 * q4 + 3];
                    s1 += g4[0] * w1[4 * q4] + g4[1] * w1[4 * q4 + 1] + g4[2] * w1[4 * q4 + 2] + g4[3] * w1[4 * q4 + 3]; }
                run0 += (fminf(s0, 0.f) - log1pf(__expf(-fabsf(s0)))) * (1.f / 16.f); run1 += (fminf(s1, 0.f) - log1pf(__expf(-fabsf(s1)))) * (1.f / 16.f);
                bc0[i] = run0; bc1[i] = run1; }
            cpart[c8 * 128 + d0] = run0; cpart[c8 * 128 + d0 + 1] = run1;
            __syncthreads();
            float pre0 = 0.f, pre1 = 0.f, bl0 = 0.f, bl1 = 0.f;
#pragma unroll
            for (int q = 0; q < 8; ++q) { const float a0 = cpart[q * 128 + d0], a1 = cpart[q * 128 + d0 + 1]; bl0 += a0; bl1 += a1; if (q < c8) { pre0 += a0; pre1 += a1; } }
            if (c8 == 0) { decl[d0] = __expf(bl0); decl[d0 + 1] = __expf(bl1); }
            { u32x4 ke0, ke1; unsigned* ke0p = (unsigned*)&ke0; unsigned* ke1p = (unsigned*)&ke1; float kel0[8], kel1[8];
#pragma unroll
              for (int i = 0; i < 8; ++i) { const float bb0 = pre0 + bc0[i], bb1 = pre1 + bc1[i];
                  const float q0 = bflo(qr[i]), q1 = bfhi(qr[i]), k0 = bflo(kr[i]), k1 = bfhi(kr[i]);
                  const int c = c8 * 8 + i;
                  *(LAS unsigned*)(Qg + c * 272 + d0 * 2) = cvtpk(q0 * __expf(bb0), q1 * __expf(bb1));
                  *(LAS unsigned*)(Kg + c * 272 + d0 * 2) = cvtpk(k0 * __expf(-bb0), k1 * __expf(-bb1));
                  kel0[i] = k0 * __expf(bl0 - bb0); kel1[i] = k1 * __expf(bl1 - bb1); }
              ke0.x = cvtpk(kel0[0], kel0[1]); ke0.y = cvtpk(kel0[2], kel0[3]); ke0.z = cvtpk(kel0[4], kel0[5]); ke0.w = cvtpk(kel0[6], kel0[7]);
              ke1.x = cvtpk(kel1[0], kel1[1]); ke1.y = cvtpk(kel1[2], kel1[3]); ke1.z = cvtpk(kel1[4], kel1[5]); ke1.w = cvtpk(kel1[6], kel1[7]);
              (void)ke0p; (void)ke1p;
              *(LAS u32x4*)(KeT + d0 * 144 + c8 * 16) = ke0; *(LAS u32x4*)(KeT + (d0 + 1) * 144 + c8 * 16) = ke1; }
            __syncthreads();
            if (n + 1 < SEQ / 64) GLA_LOAD(n + 1);
            if (wave < 4) {
                const int ct = wave >> 1, et = wave & 1;
                f32x16 oacc;
#pragma unroll
                for (int i = 0; i < 16; ++i) oacc[i] = 0.f;
                bf16x8 qa[8];
#pragma unroll
                for (int ks = 0; ks < 8; ++ks) qa[ks] = *(const LAS bf16x8*)(Qg + (ct * 32 + r) * 272 + ks * 32 + hf * 16);
#pragma unroll
                for (int ks = 0; ks < 8; ++ks) { const bf16x8 sb = *(const LAS bf16x8*)(STl + (et * 32 + r) * 272 + ks * 32 + hf * 16);
                    oacc = __builtin_amdgcn_mfma_f32_32x32x16_bf16(qa[ks], sb, oacc, 0, 0, 0); }
                for (int st = 0; st <= ct; ++st) {
                    f32x16 X;
#pragma unroll
                    for (int i = 0; i < 16; ++i) X[i] = 0.f;
#pragma unroll
                    for (int ks = 0; ks < 8; ++ks) { const bf16x8 ka = *(const LAS bf16x8*)(Kg + (st * 32 + r) * 272 + ks * 32 + hf * 16);
                        X = __builtin_amdgcn_mfma_f32_32x32x16_bf16(ka, qa[ks], X, 0, 0, 0); }
                    if (st == ct) {
#pragma unroll
                        for (int i = 0; i < 16; ++i) X[i] = (crow(i, hf) <= r) ? X[i] : 0.f; }
#pragma unroll
                    for (int s2 = 0; s2 < 2; ++s2) {
                        u32x4 pw; pw.x = cvtpk(X[8 * s2 + 0], X[8 * s2 + 1]); pw.y = cvtpk(X[8 * s2 + 2], X[8 * s2 + 3]); pw.z = cvtpk(X[8 * s2 + 4], X[8 * s2 + 5]); pw.w = cvtpk(X[8 * s2 + 6], X[8 * s2 + 7]);
                        const LAS unsigned char* vp = VTl + (et * 32 + r) * 144 + (st * 32 + 16 * s2 + 4 * hf) * 2;
                        const u32x2 lo2 = *(const LAS u32x2*)vp, hi2 = *(const LAS u32x2*)(vp + 16);
                        oacc = __builtin_amdgcn_mfma_f32_32x32x16_bf16(__builtin_bit_cast(bf16x8, pw), __builtin_bit_cast(bf16x8, (u32x4){lo2.x, lo2.y, hi2.x, hi2.y}), oacc, 0, 0, 0); }
                }
                bf16_t* op = yb + (tok0 + (size_t)n * 64 + ct * 32 + 4 * hf) * 1024 + h * 256 + es * 64 + et * 32 + r;
#pragma unroll
                for (int i = 0; i < 16; ++i) op[(size_t)((i & 3) + 8 * (i >> 2)) * 1024] = (bf16_t)f2bf(oacc[i]);
            }
#pragma unroll
            for (int i = 0; i < 16; ++i) sacc[i] *= decl[sdt * 32 + crow(i, hf)];
#pragma unroll
            for (int ks = 0; ks < 4; ++ks) { const bf16x8 ka = *(const LAS bf16x8*)(KeT + (sdt * 32 + r) * 144 + ks * 32 + hf * 16);
                const bf16x8 vb = *(const LAS bf16x8*)(VTl + (set_ * 32 + r) * 144 + ks * 32 + hf * 16);
                sacc = __builtin_amdgcn_mfma_f32_32x32x16_bf16(ka, vb, sacc, 0, 0, 0); }
            __syncthreads();
#pragma unroll
            for (int i4 = 0; i4 < 4; ++i4)
                *(LAS u32x2*)(STl + (set_ * 32 + r) * 272 + (sdt * 32 + 8 * i4 + 4 * hf) * 2) = (u32x2){cvtpk(sacc[4 * i4], sacc[4 * i4 + 1]), cvtpk(sacc[4 * i4 + 2], sacc[4 * i4 + 3])};
        }
#undef GLA_LOAD
        __syncthreads();
    }
    {   PHASE_IDS
        LAS unsigned char* Kl = lds;
        LAS unsigned char* Vl = lds + 36864;
        LAS float* tabL = (LAS float*)(lds + 71680);
        LAS int* upre = (LAS int*)(lds + 92160);
        LAS int* qinfo = (LAS int*)(lds + 98304) + wave * 32;
        LAS int* sch = (LAS int*)(lds + LDS_MISC);
        __syncthreads();
        for (int i = tid; i < 8 * 640; i += NTHR) { const int hh = i / 640, d = i % 640 - 255; tabL[i] = d < 0 ? -INFINITY : (d < 128 ? tab[hh * 128 + d] : tab[1024 + hh]); }
        if (wave == 0) {
            int loc[16]; int sum = 0;
#pragma unroll
            for (int q = 0; q < 16; ++q) { const int c = (int)__hip_atomic_load(&ctl[CW_LCNT + lane * 16 + q], __ATOMIC_RELAXED, __HIP_MEMORY_SCOPE_AGENT); loc[q] = sum; sum += (256 + c + MB_CH - 1) / MB_CH; }
            int incl = sum;
            for (int off = 1; off < 64; off <<= 1) { const int o = __shfl_up(incl, off); if (lane >= off) incl += o; }
            const int excl = incl - sum;
#pragma unroll
            for (int q = 0; q < 16; ++q) upre[lane * 16 + q] = excl + loc[q];
            if (lane == 63) upre[1024] = incl;
        }
        __syncthreads();
        const int nunits = upre[1024];
        const int r = lane & 31, hf = lane >> 5;
        for (;;) {
            __syncthreads();
            if (tid == 0) sch[0] = (int)atomicAdd(&ctl[CW_QCTR], 1u);
            __syncthreads();
            const int un = sch[0];
            if (un >= nunits) break;
            int lo_ = 0, hi_ = 1024;
            while (hi_ - lo_ > 1) { const int mid = (lo_ + hi_) >> 1; if (upre[mid] <= un) lo_ = mid; else hi_ = mid; }
            const int li = lo_, ch = un - upre[li], bh = li >> 5, n = li & 31, b = bh >> 3, h = bh & 7;
            const int total = 256 + (int)__hip_atomic_load(&ctl[CW_LCNT + li], __ATOMIC_RELAXED, __HIP_MEMORY_SCOPE_AGENT);
            const int e0 = ch * MB_CH, nent = (total - e0) < MB_CH ? (total - e0) : MB_CH, ngr = (nent + 31) >> 5;
#pragma unroll
            for (int q = 0; q < 4; ++q) { const int idx = tid + q * NTHR; const int key = idx >> 3, c = idx & 7;
                const u32x4 kv = *(const u32x4*)(Km + (size_t)(b * SEQ + n * 256 + key) * 512 + h * 64 + c * 8);
                *(LAS u32x4*)(Kl + key * 144 + (c << 4)) = kv;
                const int dim = idx >> 5, kc = idx & 31;
                const u32x4 vv = *(const u32x4*)(VT + ((size_t)bh * 64 + dim) * 8192 + n * 256 + kc * 8);
                *(LAS u32x2*)(Vl + dim * 520 + (kc << 4)) = (u32x2){vv.x, vv.y};
                *(LAS u32x2*)(Vl + dim * 520 + (kc << 4) + 8) = (u32x2){vv.z, vv.w}; }
            __syncthreads();
            const unsigned short* lp = LST + (size_t)bh * LST_STRIDE + 256 * (31 * n - (n * (n - 1)) / 2);
            const float t31 = tab[1024 + h];
            const LAS unsigned char* kbase = Kl + r * 144 + hf * 16; const LAS unsigned char* vbase = Vl + r * 520 + hf * 8;
            for (int gi = wave; gi < ngr; gi += NWAVES) {
                const int eidx = e0 + gi * 32 + r; const bool valid = eidx < total;
                int t = n * 256, part = 3;
                if (valid) { if (eidx < 256) t = n * 256 + eidx; else { const unsigned ent = lp[eidx - 256]; t = (int)(ent >> 2); part = (int)(ent & 3u); } }
                if (hf == 0) qinfo[r] = valid ? ((t << 2) | part) : -1;
                const bf16_t* qp = Qm + (size_t)(b * SEQ + t) * 512 + h * 64 + 8 * hf;
                bf16x8 bq[4];
#pragma unroll
                for (int s4 = 0; s4 < 4; ++s4) bq[s4] = *(const bf16x8*)(qp + 16 * s4);
                f32x16 st[8];
#pragma unroll
                for (int kt = 0; kt < 8; ++kt) {
#pragma unroll
                    for (int i = 0; i < 16; ++i) st[kt][i] = 0.f;
#pragma unroll
                    for (int s4 = 0; s4 < 4; ++s4) { const bf16x8 a = *(const LAS bf16x8*)(kbase + kt * 4608 + s4 * 32);
                        st[kt] = __builtin_amdgcn_mfma_f32_32x32x16_bf16(a, bq[s4], st[kt], 0, 0, 0); }
                }
                const int rel = t - n * 256;
                const bool near = __any(valid && rel < 383);
                float cadd = t31;
                if (near) { cadd = 0.f;
                    const LAS float* tb = tabL + h * 640 + (rel < 383 ? rel : 383) - 4 * hf;
#pragma unroll
                    for (int kt = 0; kt < 8; ++kt)
#pragma unroll
                        for (int i = 0; i < 16; ++i) st[kt][i] += tb[255 - kt * 32 - (i & 3) - 8 * (i >> 2)]; }
                float mx = -INFINITY;
#pragma unroll
                for (int kt = 0; kt < 8; ++kt)
#pragma unroll
                    for (int i = 0; i < 16; ++i) mx = fmaxf(mx, st[kt][i]);
                mx = fmaxf(mx, __shfl_xor(mx, 32));
                float l = 0.f;
#pragma unroll
                for (int kt = 0; kt < 8; ++kt)
#pragma unroll
                    for (int i = 0; i < 16; ++i) { const float p = __expf(st[kt][i] - mx); st[kt][i] = p; l += p; }
                l += __shfl_xor(l, 32);
                f32x16 o0, o1;
#pragma unroll
                for (int i = 0; i < 16; ++i) { o0[i] = 0.f; o1[i] = 0.f; }
#pragma unroll
                for (int kt = 0; kt < 8; ++kt)
#pragma unroll
                    for (int s2 = 0; s2 < 2; ++s2) {
                        u32x4 pw; pw.x = cvtpk(st[kt][8 * s2 + 0], st[kt][8 * s2 + 1]); pw.y = cvtpk(st[kt][8 * s2 + 2], st[kt][8 * s2 + 3]);
                        pw.z = cvtpk(st[kt][8 * s2 + 4], st[kt][8 * s2 + 5]); pw.w = cvtpk(st[kt][8 * s2 + 6], st[kt][8 * s2 + 7]);
                        const bf16x8 pa = __builtin_bit_cast(bf16x8, pw);
#pragma unroll
                        for (int dt = 0; dt < 2; ++dt) {
                            const u32x2 lo2 = *(const LAS u32x2*)(vbase + dt * 16640 + kt * 64 + s2 * 32), hi2 = *(const LAS u32x2*)(vbase + dt * 16640 + kt * 64 + s2 * 32 + 16);
                            const bf16x8 vb = __builtin_bit_cast(bf16x8, (u32x4){lo2.x, lo2.y, hi2.x, hi2.y});
                            if (dt == 0) o0 = __builtin_amdgcn_mfma_f32_32x32x16_bf16(pa, vb, o0, 0, 0, 0); else o1 = __builtin_amdgcn_mfma_f32_32x32x16_bf16(pa, vb, o1, 0, 0, 0); }
                    }
                asm volatile("s_waitcnt lgkmcnt(0)" ::: "memory");
#pragma unroll
                for (int i = 0; i < 16; ++i) { const int qi = qinfo[crow(i, hf)];
                    if (qi >= 0) { bf16_t* pr = PO + (((size_t)bh * SEQ + (qi >> 2)) * 4 + (qi & 3)) * 64;
                        pr[r] = (bf16_t)f2bf(o0[i]); pr[32 + r] = (bf16_t)f2bf(o1[i]); } }
                if (hf == 0 && valid) { float* mp = ML + (((size_t)bh * SEQ + t) * 4 + part) * 2; mp[0] = mx + cadd; mp[1] = l; }
                asm volatile("s_waitcnt lgkmcnt(0)" ::: "memory");
            }
        }
    }
    GRID_BAR();

    { PHASE_IDS
    for (int it = gw; it < 32 * SEQ; it += NGW) {
        const int bh = it >> 13, t = it & (SEQ - 1), b = bh >> 3, h = bh & 7, j = t >> 8, nsel = j < 3 ? j : 3;
        const float* mp = ML + (size_t)it * 8; const bf16_t* pr = PO + (size_t)it * 256 + lane;
        float M = mp[6];
        for (int p = 0; p < nsel; ++p) M = fmaxf(M, mp[2 * p]);
        float w = __expf(mp[6] - M), den = w * mp[7], o = w * bf2f(pr[192]);
        for (int p = 0; p < nsel; ++p) { w = __expf(mp[2 * p] - M); den += w * mp[2 * p + 1]; o += w * bf2f(pr[64 * p]); }
        ya[(size_t)(b * SEQ + t) * 512 + h * 64 + lane] = (bf16_t)f2bf(o / den);
    }
    for (int m = gw; m < TT; m += NGW) {
        u32x4* yp = (u32x4*)(yb + (size_t)m * 1024 + lane * 16); const u32x4* rp = (const u32x4*)(Rb + (size_t)m * 1024 + lane * 16);
        const u32x4 a0 = yp[0], a1 = yp[1], r0 = rp[0], r1 = rp[1];
        float v[16] = {bflo(a0.x), bfhi(a0.x), bflo(a0.y), bfhi(a0.y), bflo(a0.z), bfhi(a0.z), bflo(a0.w), bfhi(a0.w), bflo(a1.x), bfhi(a1.x), bflo(a1.y), bfhi(a1.y), bflo(a1.z), bfhi(a1.z), bflo(a1.w), bfhi(a1.w)};
        const float g[16] = {bflo(r0.x), bfhi(r0.x), bflo(r0.y), bfhi(r0.y), bflo(r0.z), bfhi(r0.z), bflo(r0.w), bfhi(r0.w), bflo(r1.x), bfhi(r1.x), bflo(r1.y), bfhi(r1.y), bflo(r1.z), bfhi(r1.z), bflo(r1.w), bfhi(r1.w)};
        float ss = 0.f;
#pragma unroll
        for (int i = 0; i < 16; ++i) ss += v[i] * v[i];
        ss += __shfl_xor(ss, 1); ss += __shfl_xor(ss, 2); ss += __shfl_xor(ss, 4); ss += __shfl_xor(ss, 8);
        const float rs = rsqrtf(ss * (1.f / 256.f) + 1e-6f); const float* gn = gla_norm + (lane & 15) * 16;
#pragma unroll
        for (int i = 0; i < 16; ++i) v[i] = v[i] * rs * gn[i] * g[i];
        yp[0] = (u32x4){pk2(v[0], v[1]), pk2(v[2], v[3]), pk2(v[4], v[5]), pk2(v[6], v[7])}; yp[1] = (u32x4){pk2(v[8], v[9]), pk2(v[10], v[11]), pk2(v[12], v[13]), pk2(v[14], v[15])};
    }
    }
    GRID_BAR();

    {
        PHASE_IDS
        for (int it = gw; it < 32 * 16 * 64; it += NGW) {
            const int e = it >> 10, q = it & 1023, kb = q >> 6, nb = q & 63;
            const int dr0 = nb * 32, pn = dr0 >> 8, bj = (dr0 >> 7) & 1, cc = dr0 & 127;
            const float* src = (bj ? w_up : w_gate) + (size_t)e * 1024 * 1024;
            transpose_item(src, 1024, pn * 128 + cc, kb * 64, WguT + (size_t)e * 2048 * 1024, 1024, dr0, scr, lane, 32);
        }
        __syncthreads();
        { pg8::DenseOrder S; S.init(TT, 1024, G, bx, ya, 512, WpaT, 512); EpiMix<0> E{GT, MIX};
          pg8::gemm_phase<EpiMix<0>, pg8::DenseOrder, false>(lds, 512, 512, 8, S, E); }
        asm volatile("s_waitcnt vmcnt(0)" ::: "memory"); __syncthreads();
        { pg8::DenseOrder S; S.init(TT, 1024, G, bx, yb, 1024, WpbT, 1024); EpiMix<1> E{GT, MIX};
          pg8::gemm_phase<EpiMix<1>, pg8::DenseOrder, false>(lds, 1024, 1024, 16, S, E); }
    }
    GRID_BAR();

    {
        pg8::DenseOrder S; S.init(TT, 1024, G, bx, MIX, 1024, WoutT, 1024); EpiX1 E{x, mod + 2048, out};
        pg8::gemm_phase<EpiX1, pg8::DenseOrder, false>(lds, 1024, 1024, 16, S, E);
    }
    GRID_BAR();

    {
        PHASE_IDS
        for (int it = gw; it < 32 * 16 * 32; it += NGW) { const int e = it / 512, q = it % 512, kb = q / 32, nb = q % 32;
            transpose_item(w_down + (size_t)e * 1024 * 1024, 1024, nb * 32, kb * 64, WdT + (size_t)e * 1024 * 1024, 1024, nb * 32, scr, lane, 32); }
        __syncthreads();
        LAS float* wr_t = (LAS float*)lds;
        for (int i = tid; i < 32 * 1024; i += NTHR) { const int k = i >> 5, e = i & 31; wr_t[e * 1024 + k] = w_router[i]; }
        __syncthreads();
        for (int m = gw; m < TT; m += NGW) {
            const int b = m >> 13;
            const f32x4* xr = (const f32x4*)(out + (size_t)m * DM) + lane;
            f32x4 v[4]; float s = 0.f;
#pragma unroll
            for (int j = 0; j < 4; ++j) { v[j] = xr[64 * j]; s += (v[j][0] * v[j][0] + v[j][1] * v[j][1]) + (v[j][2] * v[j][2] + v[j][3] * v[j][3]); }
            const float rs = rsqrtf(wave_sum(s) * (1.f / DM) + 1e-6f);
            unsigned long long* o8 = (unsigned long long*)(H2 + (size_t)m * DM) + lane;
#pragma unroll
            for (int j = 0; j < 4; ++j) { const int c = 256 * j + 4 * lane;
                const f32x4 w = *(const f32x4*)(norm_ffn + c); const f32x4 sh = *(const f32x4*)(mod + b * 6144 + 3072 + c), sc = *(const f32x4*)(mod + b * 6144 + 4096 + c);
                v[j] = (v[j] * rs) * w * (sc + 1.f) + sh;
                o8[64 * j] = (unsigned long long)pk2(v[j][0], v[j][1]) | ((unsigned long long)pk2(v[j][2], v[j][3]) << 32); }
            float mylogit = 0.f;
            for (int e = 0; e < 32; ++e) { float a = 0.f;
#pragma unroll
                for (int j = 0; j < 4; ++j) { const f32x4 w = *(const LAS f32x4*)(wr_t + e * 1024 + 256 * j + 4 * lane); a += (v[j][0] * w[0] + v[j][1] * w[1]) + (v[j][2] * w[2] + v[j][3] * w[3]); }
                a = wave_sum(a); if (lane == e) mylogit = a + b_router[e]; }
            float g = lane < 32 ? mylogit : -INFINITY;
            float tv[4]; int ti[4];
#pragma unroll
            for (int k = 0; k < 4; ++k) { float vv = g; int idx = lane;
                for (int off = 32; off; off >>= 1) { const float ov = __shfl_xor(vv, off); const int oi = __shfl_xor(idx, off); if (ov > vv || (ov == vv && oi < idx)) { vv = ov; idx = oi; } }
                tv[k] = vv; ti[k] = idx; if (lane == idx) g = -INFINITY; }
            if (lane < 4) {
                const float e1 = __expf(tv[1] - tv[0]), e2 = __expf(tv[2] - tv[0]), e3 = __expf(tv[3] - tv[0]); const float inv = 1.f / (1.f + e1 + e2 + e3);
                const float wk = (lane == 0 ? 1.f : (lane == 1 ? e1 : (lane == 2 ? e2 : e3))) * inv;
                const int ek = lane == 0 ? ti[0] : (lane == 1 ? ti[1] : (lane == 2 ? ti[2] : ti[3]));
                topw[m * 4 + lane] = wk;
                const unsigned pos = atomicAdd(&ctl[CW_CNT + ek], 1u);
                list[(size_t)ek * TT + pos] = m * 4 + lane;
            }
        }
    }
    GRID_BAR();

    {
        PHASE_IDS
        LAS int* blkE = (LAS int*)(lds + LDS_BLKE); LAS int* blkR = (LAS int*)(lds + LDS_BLKR); LAS int* idxT = (LAS int*)(lds + LDS_IDX); LAS int* misc = (LAS int*)(lds + LDS_MISC);
        if (tid == 0) { int nb = 0;
            for (int e = 0; e < 32; ++e) { const int c = (int)__hip_atomic_load(&ctl[CW_CNT + e], __ATOMIC_RELAXED, __HIP_MEMORY_SCOPE_AGENT); const int k = (c + 255) >> 8;
                for (int q = 0; q < k; ++q) { blkE[nb] = e; blkR[nb] = q * 256; ++nb; } }
            misc[1] = nb; }
        __syncthreads();
        const int nb = misc[1];
        const int cp = vcu;
        pg8::MoeOrder S1{0, nb, 8, G, cp, 1, (const char*)H2, (const char*)WguT, blkE, idxT};
        { pg8::Unit u;
          for (int i = 0; S1.next(i, u); ++i) {
              for (int rr = tid; rr < 256; rr += NTHR) { const int e = u.e; const int r = blkR[u.pm] + rr; const int cnt = (int)__hip_atomic_load(&ctl[CW_CNT + e], __ATOMIC_RELAXED, __HIP_MEMORY_SCOPE_AGENT);
                  const bool ok = r < cnt; const int a = list[(size_t)e * TT + (ok ? r : 0)];
                  idxT[i * 256 + rr] = a >> 2;
                  if (ok && u.pn == 0) dest[a] = u.pm * 256 + rr; }
          } }
        __syncthreads();
        { EpiAct E{b_gate, b_up, ACT};
          pg8::gemm_phase<EpiAct, pg8::MoeOrder, true>(lds, 1024, 1024, 16, S1, E); }
        GRID_BAR();
        const int rounds = (nb + 63) >> 6, nbA = ((rounds + 1) >> 1) * 64 < nb ? ((rounds + 1) >> 1) * 64 : nb;
        { pg8::MoeOrder S2{0, nbA, 4, G, cp, 0, (const char*)ACT, (const char*)WdT, blkE, idxT}; EpiDown E{b_down, YA, 0};
          pg8::gemm_phase<EpiDown, pg8::MoeOrder, false>(lds, 1024, 1024, 16, S2, E); }
        GRID_BAR();
        { pg8::MoeOrder S2{nbA, nb, 4, G, cp, 0, (const char*)ACT, (const char*)WdT, blkE, idxT}; EpiDown E{b_down, YBr, nbA};
          pg8::gemm_phase<EpiDown, pg8::MoeOrder, false>(lds, 1024, 1024, 16, S2, E); }
        GRID_BAR();
        for (int m = gw; m < TT; m += NGW) {
            const int b = m >> 13;
            f32x4* xr = (f32x4*)(out + (size_t)m * DM) + lane;
            f32x4 v[4];
#pragma unroll
            for (int j = 0; j < 4; ++j) v[j] = (f32x4){0.f, 0.f, 0.f, 0.f};
#pragma unroll
            for (int k = 0; k < 4; ++k) { const int sl = dest[m * 4 + k]; const float wk = topw[m * 4 + k];
                const bf16_t* yr = (sl < nbA * 256) ? (YA + (size_t)sl * 1024) : (YBr + (size_t)(sl - nbA * 256) * 1024);
                const u32x2* y2 = (const u32x2*)yr + lane;
#pragma unroll
                for (int j = 0; j < 4; ++j) { const u32x2 p = y2[64 * j]; v[j] += (f32x4){bflo(p.x), bfhi(p.x), bflo(p.y), bfhi(p.y)} * wk; } }
            float s = 0.f;
#pragma unroll
            for (int j = 0; j < 4; ++j) { const int c = 256 * j + 4 * lane; const f32x4 g2 = *(const f32x4*)(mod + b * 6144 + 5120 + c);
                v[j] = xr[64 * j] + g2 * v[j]; s += (v[j][0] * v[j][0] + v[j][1] * v[j][1]) + (v[j][2] * v[j][2] + v[j][3] * v[j][3]); }
            const float rs = rsqrtf(wave_sum(s) * (1.f / DM) + 1e-6f);
#pragma unroll
            for (int j = 0; j < 4; ++j) { const int c = 256 * j + 4 * lane; xr[64 * j] = v[j] * rs * *(const f32x4*)(norm_final + c); }
        }
    }
}

extern "C" void kernel_launch(void* const* d_in, const int* in_sizes, int n_in, void* d_out, int out_size, void* d_ws, size_t ws_size, hipStream_t stream) {
    static int grid = 0;
    if (grid == 0) {
        if (n_in != 23 || out_size != TT * DM || ws_size < WS_NEED) { fprintf(stderr, "kernel_launch: unexpected shapes (n_in %d out %d ws %zu)\n", n_in, out_size, ws_size); grid = -1; return; }
        int dev = 0, cus = 0, per_cu = 0;
        (void)hipGetDevice(&dev); (void)hipDeviceGetAttribute(&cus, hipDeviceAttributeMultiprocessorCount, dev);
        if (hipFuncSetAttribute((const void*)mega_fwd, hipFuncAttributeMaxDynamicSharedMemorySize, LDS_BYTES) != hipSuccess) { fprintf(stderr, "kernel_launch: hipFuncSetAttribute failed\n"); grid = -1; return; }
        if (hipOccupancyMaxActiveBlocksPerMultiprocessor(&per_cu, (const void*)mega_fwd, NTHR, LDS_BYTES) != hipSuccess || per_cu < 1) { fprintf(stderr, "kernel_launch: occupancy query failed (%d)\n", per_cu); (void)hipGetLastError(); grid = -1; return; }
        grid = cus;
    }
    if (grid < 0) return;
    (void)hipMemsetAsync((char*)d_ws + WS_CTL, 0, 65536, stream);
    Args a{};
    for (int i = 0; i < 23; ++i) a.in[i] = (const float*)d_in[i];
    a.out = (float*)d_out; a.ws = (unsigned char*)d_ws;
    void* kargs[] = {&a};
    hipError_t e = hipLaunchCooperativeKernel((const void*)mega_fwd, dim3(grid), dim3(NTHR), kargs, LDS_BYTES, stream);
    if (e != hipSuccess) fprintf(stderr, "cooperative launch failed: %s (grid %d)\n", hipGetErrorString(e), grid);
}
```

```cpp
#include <hip/hip_runtime.h>
#include <hip/hip_cooperative_groups.h>
#include <cstdio>
#include <cstdint>
#include <math.h>
namespace cg = cooperative_groups;
#ifndef PROBE
#define PROBE 0
#endif
#define REPN(k) ((PROBE == (k)) ? 2 : 1)
#ifndef PROBE_A0
#define PROBE_A0 0
#define PROBE_A1 1
#define PROBE_R0 0
#define PROBE_R1 1
#endif

#define LAS __attribute__((address_space(3)))
typedef unsigned short bf16_t;
typedef short bf16x8 __attribute__((ext_vector_type(8)));
typedef float f32x4 __attribute__((ext_vector_type(4)));
typedef unsigned u32x4 __attribute__((ext_vector_type(4)));
typedef unsigned u32x2 __attribute__((ext_vector_type(2)));
typedef float f32x16 __attribute__((ext_vector_type(16)));
typedef float f32x2_t __attribute__((ext_vector_type(2)));
typedef __bf16 bf16x2_t __attribute__((ext_vector_type(2)));
__device__ __forceinline__ unsigned cvtpk(float lo, float hi) { f32x2_t v = {lo, hi}; bf16x2_t b = __builtin_convertvector(v, bf16x2_t); return __builtin_bit_cast(unsigned, b); }
__device__ __forceinline__ int crow(int reg, int h) { return (reg & 3) + 8 * (reg >> 2) + 4 * h; }

constexpr int NB = 4, SEQ = 8192, DM = 1024, TT = NB * SEQ, DIN = 6672;
constexpr int NPROJ = 6656;
constexpr int NEXP = 32;
constexpr int P2_F8_FROM = 10;
constexpr int NWAVES = 8, NTHR = 512;
constexpr size_t MiB = (size_t)1 << 20;

constexpr size_t KiB = 1024;
constexpr size_t WS_CTL = 0;
constexpr size_t WS_MODP = 28 * MiB;
constexpr size_t WS_MOD = 896 * KiB;
constexpr size_t WS_TAB = 992 * KiB;
constexpr size_t WS_KMEAN = 1 * MiB;
constexpr size_t WS_GK = 1 * MiB + 256 * KiB;
constexpr size_t WS_TOPW = 3 * MiB + 256 * KiB;
constexpr size_t WS_DEST = 3 * MiB + 768 * KiB;
constexpr size_t WS_LIST = 4 * MiB + 256 * KiB;
constexpr size_t WS_WIN = 8 * MiB + 256 * KiB;
constexpr size_t WS_WPA = 21 * MiB + 768 * KiB;
constexpr size_t WS_WPB = 22 * MiB + 768 * KiB;
constexpr size_t WS_WOUT = 24 * MiB + 768 * KiB;
constexpr size_t WS_BIG = 28 * MiB;
constexpr size_t WS_GT = WS_BIG;
constexpr size_t WS_R = WS_BIG + 128 * MiB;
constexpr size_t WS_MIX = WS_R;
constexpr size_t WS_VB = WS_BIG + 192 * MiB;
constexpr size_t WS_QB = WS_BIG + 256 * MiB;
constexpr size_t WS_KB = WS_BIG + 288 * MiB;
constexpr size_t WS_QM = WS_BIG + 320 * MiB;
constexpr size_t WS_KM = WS_BIG + 352 * MiB;
constexpr size_t WS_VM = WS_BIG + 384 * MiB;
constexpr size_t WS_XN = WS_BIG + 416 * MiB;
constexpr size_t WS_XN8 = 508 * MiB;
constexpr size_t WS_WD = 508 * MiB;
constexpr size_t WS_ACT = WS_BIG;
constexpr size_t WS_WGU = 304 * MiB;
constexpr size_t WS_H2 = 432 * MiB;
constexpr size_t WS_YA = 164 * MiB;
constexpr size_t WS_VT = WS_XN;
constexpr size_t WS_YAW = WS_XN + 32 * MiB;
constexpr size_t WS_YBW = 508 * MiB;
constexpr size_t WS_ML = WS_VM;
constexpr size_t WS_LST = WS_VM + 8 * MiB;
constexpr size_t WS_NEED = 572 * MiB;
static_assert(WS_WOUT + 2 * MiB <= WS_BIG && WS_XN + 64 * MiB <= WS_WD && WS_WD + 64 * MiB <= WS_NEED, "ws map");
static_assert(WS_ACT + 136 * MiB <= WS_YA && WS_YA + 272 * MiB <= WS_WD && WS_WGU + 128 * MiB <= WS_H2 && WS_H2 + 64 * MiB <= WS_WD, "moe map");

constexpr int CW_CNT = 0;
constexpr int CW_QCTR = 64;
constexpr int CW_ERR = 128;
constexpr int CW_BAR = 4096;
constexpr int CW_LCNT = 1024;
constexpr int MB_CH = 1024;
constexpr int LST_STRIDE = 126976;
constexpr int GLA_NSPLIT = 2, GLA_CPS = (SEQ / 64) / GLA_NSPLIT;
constexpr size_t WS_SLOC = 432 * MiB;
constexpr size_t WS_PN = WS_SLOC + 9 * MiB;
static_assert(GLA_NSPLIT == 1 || GLA_NSPLIT == 2, "the correction pass below handles one later segment");

constexpr int RING_BYTES = 131072;
constexpr int LDS_IDX = RING_BYTES;
constexpr int LDS_BLKE = LDS_IDX + 17408;
constexpr int LDS_BLKR = LDS_BLKE + 2176;
constexpr int LDS_MISC = LDS_BLKR + 2176;
constexpr int LDS_PTAB = LDS_MISC + 256;
constexpr int LDS_BYTES = LDS_PTAB + 256;
static_assert(LDS_BYTES <= 163840, "LDS");

__device__ __forceinline__ unsigned f2bf(float f) { unsigned u = __builtin_bit_cast(unsigned, f); return (u + 0x7fffu + ((u >> 16) & 1u)) >> 16; }
__device__ __forceinline__ unsigned pk2(float lo, float hi) { return f2bf(lo) | (f2bf(hi) << 16); }
__device__ __forceinline__ float bf2f(unsigned short b) { return __builtin_bit_cast(float, (unsigned)b << 16); }
__device__ __forceinline__ float bflo(unsigned w) { return __builtin_bit_cast(float, w << 16); }
__device__ __forceinline__ float bfhi(unsigned w) { return __builtin_bit_cast(float, w & 0xffff0000u); }
__device__ __forceinline__ float sigm(float x) { return __builtin_amdgcn_rcpf(1.f + __builtin_amdgcn_exp2f(-1.4426950408889634f * x)); }
__device__ __forceinline__ float wave_sum(float v) {
#pragma unroll
    for (int o = 1; o < 64; o <<= 1) v += __shfl_xor(v, o);
    return v;
}

namespace pg8 {
constexpr int BM = 256, BK = 64, HALF = 128, HTB = HALF * BK * 2, NXCD = 8, WGM = 8;
__host__ __device__ __forceinline__ int lds_byte(int r, int c) { const int st = (r >> 4) * 2 + (c >> 5), rr = r & 15, cc = c & 31, ob = rr * 64 + cc * 2; return st * 1024 + (ob ^ (((ob >> 9) & 1) << 5)); }
__host__ __device__ __forceinline__ void stage_rc(int b, int& R, int& C) { const int st = b / 1024, sb = b % 1024, swz = sb ^ (((sb >> 9) & 1) << 5); R = (st >> 1) * 16 + swz / 64; C = (st & 1) * 32 + (swz % 64) / 2; }
__host__ __device__ __forceinline__ int perm32(int rho) { const int n = rho >> 4, i = rho & 15; return 8 * (i >> 2) + 4 * n + (i & 3); }

struct Unit { int pm, pn, e; const char* A; const char* B; };

struct DenseOrder {
    int nM, nN, nwg, G, c, reps; const char* A0; const char* B0; size_t astep, bstep;
    __device__ __forceinline__ void init(int M, int N, int G_, int c_, const void* A, int lda, const void* B, int ldb) { nM = M / BM; nN = N / BM; nwg = nM * nN; G = G_; c = c_; reps = 1; A0 = (const char*)A; B0 = (const char*)B; astep = (size_t)BM * lda * 2; bstep = (size_t)BM * ldb * 2; }
    __device__ __forceinline__ bool next(int i, Unit& u) const {
        const long L = (long)i * G + c; if (L >= (long)nwg * reps) return false;
        int wgid = (int)(L % nwg); { const int q = nwg / NXCD, r = nwg % NXCD, xcd = wgid % NXCD, off = wgid / NXCD; wgid = (xcd < r ? xcd * (q + 1) : r * (q + 1) + (xcd - r) * q) + off; }
        const int nig = WGM * nN, gid = wgid / nig, fm = gid * WGM, gsz = (nM - fm) < WGM ? (nM - fm) : WGM;
        u.pm = fm + ((wgid % nig) % gsz); u.pn = (wgid % nig) / gsz; u.e = 0;
        u.A = A0 + (size_t)u.pm * astep; u.B = B0 + (size_t)u.pn * bstep; return true;
    }
    __device__ __forceinline__ int gidx(int, int) const { return 0; }
};

template <bool gather, int ncol, int RB  > struct MoeOrder {
    int lo, hi, G, cp; const char* A0; const char* B0; const LAS int* blkE; const LAS int* idx;
    __device__ __forceinline__ bool next(int i, Unit& u) const {
        const long L = (long)i * G + cp; const int b = lo + (int)(L / ncol); if (b >= hi) return false;
        u.pm = b; u.pn = (int)(L % ncol); u.e = blkE[b];
        u.A = gather ? A0 : A0 + (size_t)b * (256 * RB); u.B = B0 + ((size_t)u.e * ncol + u.pn) * (size_t)(256 * RB); return true;
    }
    __device__ __forceinline__ int gidx(int ui, int row) const { return idx[ui * 256 + row]; }
};

#define PG8_WAIT_V(n) asm volatile("s_waitcnt vmcnt(" #n ")" ::: "memory")
#define PG8_WAIT_L(n) asm volatile("s_waitcnt lgkmcnt(" #n ")" ::: "memory")
#define PG8_BAR __builtin_amdgcn_s_barrier()
#define PG8_SCHED __builtin_amdgcn_sched_barrier(0)

template <class Epi, class Sched, bool GATHER, int lda, int ldb, int nt, bool FP8 = false>
__device__ __forceinline__ void gemm_phase(LAS unsigned char* lds, const Sched& S, const Epi& E) {
    int tid_ = threadIdx.x; asm volatile("" : "+v"(tid_));
    const int tid = tid_, wid = __builtin_amdgcn_readfirstlane(tid >> 6), lane = tid & 63, wr = wid >> 2, wc = wid & 3, fr = lane & 15, fq = lane >> 4;
    unsigned voffA[2], voffA1[2], voffB[2];
    { int R, C; stage_rc(tid * 16, R, C); const int Rb = Epi::PERM ? ((R & ~31) + perm32(R & 31)) : R;
      voffA[0] = (unsigned)(R * lda + C) * 2u; voffA[1] = GATHER ? voffA[0] : 0u; voffA1[0] = voffA[0]; voffA1[1] = voffA[1]; voffB[0] = (unsigned)(Rb * ldb + C) * 2u; voffB[1] = 0u; }
    constexpr size_t ASTEP2 = GATHER ? 0 : (size_t)64 * lda * 2, BSTEP2 = (size_t)64 * ldb * 2;
    const size_t kstep = (size_t)(BK * 2);
    const size_t hstepA = GATHER ? 0 : (size_t)HALF * lda * 2, hstepB = (size_t)HALF * ldb * 2;
    const unsigned ldsw = (unsigned)wid * 1024u;
    const int aoff = FP8 ? lds_byte(wr * 64 + fr, fq * 16) : lds_byte(wr * 64 + fr, fq * 8), boff = FP8 ? lds_byte(wc * 32 + fr, fq * 16) : lds_byte(wc * 32 + fr, fq * 8);
#define PG8_SA(b, h) (((b) * 2 + (h)) * HTB)
#define PG8_SB(b, h) ((4 + (b) * 2 + (h)) * HTB)
#define PG8_STAGE_A(bufoff, gbase, voff) do { _Pragma("unroll") for (int _i = 0; _i < 2; ++_i) \
        __builtin_amdgcn_global_load_lds((const unsigned*)((const char*)(gbase) + _i * ASTEP2 + (voff)[GATHER ? _i : 0]), (LAS unsigned*)(lds + (bufoff) + ldsw + _i * 8192), 16, 0, 0); } while (0)
#define PG8_STAGE_B(bufoff, gbase, voff) do { _Pragma("unroll") for (int _i = 0; _i < 2; ++_i) \
        __builtin_amdgcn_global_load_lds((const unsigned*)((const char*)(gbase) + _i * BSTEP2 + (voff)[0]), (LAS unsigned*)(lds + (bufoff) + ldsw + _i * 8192), 16, 0, 0); } while (0)
#define PG8_LDA(dst, b, h) do { if constexpr (FP8) { _Pragma("unroll") for (int m = 0; m < 4; ++m) { const v4i_ lo_ = *(const LAS v4i_*)(lds + PG8_SA(b, h) + aoff + m * 2048), hi_ = *(const LAS v4i_*)(lds + PG8_SA(b, h) + aoff + m * 2048 + 16); \
            A8[m] = (v8i_){lo_[0], lo_[1], lo_[2], lo_[3], hi_[0], hi_[1], hi_[2], hi_[3]}; } } \
        else { _Pragma("unroll") for (int m = 0; m < 4; ++m) _Pragma("unroll") for (int k = 0; k < 2; ++k) dst[m][k] = *(const LAS bf16x8*)(lds + PG8_SA(b, h) + aoff + m * 2048 + k * 1024); } } while (0)
#define PG8_LDB(dst, dst8, b, h) do { if constexpr (FP8) { _Pragma("unroll") for (int n = 0; n < 2; ++n) { const v4i_ lo_ = *(const LAS v4i_*)(lds + PG8_SB(b, h) + boff + n * 2048), hi_ = *(const LAS v4i_*)(lds + PG8_SB(b, h) + boff + n * 2048 + 16); \
            dst8[n] = (v8i_){lo_[0], lo_[1], lo_[2], lo_[3], hi_[0], hi_[1], hi_[2], hi_[3]}; } } \
        else { _Pragma("unroll") for (int n = 0; n < 2; ++n) _Pragma("unroll") for (int k = 0; k < 2; ++k) dst[n][k] = *(const LAS bf16x8*)(lds + PG8_SB(b, h) + boff + n * 2048 + k * 1024); } } while (0)
#define PG8_MMA(ai, bj, At, Bt, Bt8) do { __builtin_amdgcn_s_setprio(1); _Pragma("unroll") for (int m = 0; m < 4; ++m) _Pragma("unroll") for (int n = 0; n < 2; ++n) { \
        if constexpr (FP8) asm volatile("v_mfma_scale_f32_16x16x128_f8f6f4 %0, %1, %2, %0, %3, %3 op_sel_hi:[0,0,0]" : "+v"(acc[ai][bj][m][n]) : "v"(Bt8[n]), "v"(A8[m]), "v"(scl8));   \
        else { _Pragma("unroll") for (int k = 0; k < 2; ++k) acc[ai][bj][m][n] = __builtin_amdgcn_mfma_f32_16x16x32_bf16(Bt[n][k], At[m][k], acc[ai][bj][m][n], 0, 0, 0); } } \
        __builtin_amdgcn_s_setprio(0); } while (0)
#define PG8_GLOAD(uix) do { if constexpr (GATHER) { _Pragma("unroll") for (int _i = 0; _i < 2; ++_i) { int R_, C_; stage_rc(tid * 16 + _i * 8192, R_, C_); \
        voffA[_i] = (unsigned)(S.gidx(uix, R_) * lda + C_) * 2u; voffA1[_i] = (unsigned)(S.gidx(uix, 128 + R_) * lda + C_) * 2u; } } } while (0)
    Unit cur, nxt; int ui = 0;
    if (!S.next(0, cur)) return;
    f32x4 acc[2][2][4][2];
#pragma unroll
    for (int a = 0; a < 2; ++a)
#pragma unroll
        for (int b = 0; b < 2; ++b)
#pragma unroll
            for (int m = 0; m < 4; ++m)
#pragma unroll
                for (int n = 0; n < 2; ++n) acc[a][b][m][n] = (f32x4){0.f, 0.f, 0.f, 0.f};
    typedef int v8i_ __attribute__((ext_vector_type(8))); typedef int v4i_ __attribute__((ext_vector_type(4)));
    bf16x8 At[4][2], B0[2][2], B1[2][2]; v8i_ A8[4], B80[2], B81[2]; int scl8 = 0x7f7f7f7f; asm volatile("" : "+v"(scl8)); (void)scl8;
    const char* cA = cur.A; const char* cB = cur.B;
    PG8_GLOAD(0);
    PG8_STAGE_B(PG8_SB(0, 0), cB, voffB); PG8_STAGE_B(PG8_SB(0, 1), cB + hstepB, voffB); PG8_STAGE_A(PG8_SA(0, 0), cA, voffA); PG8_STAGE_A(PG8_SA(0, 1), cA + hstepA, voffA1);
    if (wr == 1) PG8_BAR;
    PG8_WAIT_V(2); PG8_BAR;
    PG8_STAGE_B(PG8_SB(1, 0), cB + kstep, voffB); PG8_STAGE_A(PG8_SA(1, 0), cA + kstep, voffA); PG8_STAGE_B(PG8_SB(1, 1), cB + hstepB + kstep, voffB);
    PG8_WAIT_V(6); PG8_BAR;
    for (;;) {
        const bool has_next = S.next(ui + 1, nxt);
        const char* nA = has_next ? nxt.A : cA; const char* nB = has_next ? nxt.B : cB;
#pragma unroll 1
        for (int t = 0; t < nt; t += 2) {
            const bool last = (t == nt - 2);
            const char* a1 = cA + (size_t)(t + 1) * kstep;
            const char* a2 = last ? nA : cA + (size_t)(t + 2) * kstep; const char* b2 = last ? nB : cB + (size_t)(t + 2) * kstep;
            const char* a3 = a2 + kstep; const char* b3 = b2 + kstep;
            PG8_LDB(B0, B80, 0, 0); PG8_LDB(B1, B81, 0, 1); PG8_SCHED; PG8_LDA(At, 0, 0); PG8_STAGE_A(PG8_SA(1, 1), a1 + hstepA, voffA1);
            if (GATHER && last && has_next) { PG8_GLOAD(ui + 1); }
            PG8_WAIT_V(8); PG8_WAIT_L(0); PG8_BAR; PG8_MMA(0, 0, At, B0, B80); PG8_MMA(0, 1, At, B1, B81); PG8_BAR; PG8_SCHED;
            PG8_LDA(At, 0, 1); PG8_STAGE_B(PG8_SB(0, 0), b2, voffB); PG8_STAGE_B(PG8_SB(0, 1), b2 + hstepB, voffB); PG8_STAGE_A(PG8_SA(0, 0), a2, voffA);
            PG8_WAIT_V(8); PG8_WAIT_L(0); PG8_BAR; PG8_MMA(1, 0, At, B0, B80); PG8_MMA(1, 1, At, B1, B81); PG8_BAR; PG8_SCHED;
            PG8_LDB(B0, B80, 1, 0); PG8_LDB(B1, B81, 1, 1); PG8_SCHED; PG8_LDA(At, 1, 0); PG8_STAGE_A(PG8_SA(0, 1), a2 + hstepA, voffA1);
            PG8_WAIT_V(8); PG8_WAIT_L(0); PG8_BAR; PG8_MMA(0, 0, At, B0, B80); PG8_MMA(0, 1, At, B1, B81); PG8_BAR; PG8_SCHED;
            PG8_LDA(At, 1, 1); PG8_STAGE_B(PG8_SB(1, 0), b3, voffB); PG8_STAGE_B(PG8_SB(1, 1), b3 + hstepB, voffB); PG8_STAGE_A(PG8_SA(1, 0), a3, voffA);
            PG8_WAIT_V(8); PG8_WAIT_L(0); PG8_BAR; PG8_MMA(1, 0, At, B0, B80); PG8_MMA(1, 1, At, B1, B81); PG8_BAR; PG8_SCHED;
        }
        if (wr == 0) PG8_BAR;
        if constexpr (FP8) asm volatile("s_nop 15\n\ts_nop 15" ::: "memory");
        E(acc, cur, wr, wc, fr, fq);
        if (!has_next) break;
#pragma unroll
        for (int a = 0; a < 2; ++a)
#pragma unroll
            for (int b = 0; b < 2; ++b)
#pragma unroll
                for (int m = 0; m < 4; ++m)
#pragma unroll
                    for (int n = 0; n < 2; ++n) acc[a][b][m][n] = (f32x4){0.f, 0.f, 0.f, 0.f};
        cur = nxt; cA = nA; cB = nB; ++ui;
        if (wr == 1) PG8_BAR;
    }
    PG8_WAIT_V(0);
    PG8_BAR;
#undef PG8_SA
#undef PG8_SB
#undef PG8_STAGE_A
#undef PG8_STAGE_B
#undef PG8_LDA
#undef PG8_LDB
#undef PG8_MMA
#undef PG8_GLOAD
}
}

typedef f32x4 Acc[2][2][4][2];
__device__ __forceinline__ u32x4 pack8(f32x4 a, f32x4 b) { u32x4 w; w.x = cvtpk(a[0], a[1]); w.y = cvtpk(a[2], a[3]); w.z = cvtpk(b[0], b[1]); w.w = cvtpk(b[2], b[3]); return w; }
__device__ __forceinline__ f32x4 silu4(f32x4 v) { return (f32x4){v[0] * sigm(v[0]), v[1] * sigm(v[1]), v[2] * sigm(v[2]), v[3] * sigm(v[3])}; }
__device__ __forceinline__ f32x4 sigm4(f32x4 v) { return (f32x4){sigm(v[0]), sigm(v[1]), sigm(v[2]), sigm(v[3])}; }

struct EpiProj {
    static constexpr bool PERM = true;
    unsigned char* ws; int pn0; float pre;
    __device__ __forceinline__ void operator()(const Acc& acc, const pg8::Unit& u, int wr, int wc, int fr, int fq) const {
        const int pn = u.pn + pn0; size_t boff; int ldc, ct, fn = 0; float sc = 1.f;
        if (pn < 2) { boff = WS_QM; ldc = 512; ct = pn; sc = 0.125f; }
        else if (pn < 4) { boff = WS_KM; ldc = 512; ct = pn - 2; }
        else if (pn < 6) { boff = WS_QB; ldc = 512; ct = pn - 4; sc = 0.08838834764831845f; }
        else if (pn < 8) { boff = WS_KB; ldc = 512; ct = pn - 6; }
        else if (pn < 10) { boff = WS_VM; ldc = 512; ct = pn - 8; }
        else if (pn < 14) { boff = WS_VB; ldc = 1024; ct = pn - 10; }
        else if (pn < 18) { boff = WS_R; ldc = 1024; ct = pn - 14; fn = 1; }
        else { boff = WS_GT; ldc = 2048; ct = pn - 18; fn = 2; }
        sc *= pre;
        bf16_t* base = (bf16_t*)(ws + boff);
        const int col0 = ct * 256 + wc * 32 + 8 * fq;
#pragma unroll
        for (int ai = 0; ai < 2; ++ai)
#pragma unroll
            for (int m = 0; m < 4; ++m) { bf16_t* rowp = base + (size_t)(u.pm * 256 + ai * 128 + wr * 64 + m * 16 + fr) * ldc + col0;
#pragma unroll
                for (int bj = 0; bj < 2; ++bj) { f32x4 v0 = acc[ai][bj][m][0] * sc, v1 = acc[ai][bj][m][1] * sc;
                    if (fn == 2) {
                        v0 = sigm4(v0) * 255.f + 0.5f; v1 = sigm4(v1) * 255.f + 0.5f;
                        const unsigned w0 = (unsigned)v0[0] | ((unsigned)v0[1] << 8) | ((unsigned)v0[2] << 16) | ((unsigned)v0[3] << 24), w1 = (unsigned)v1[0] | ((unsigned)v1[1] << 8) | ((unsigned)v1[2] << 16) | ((unsigned)v1[3] << 24);
                        *(u32x2*)((unsigned char*)base + (size_t)(u.pm * 256 + ai * 128 + wr * 64 + m * 16 + fr) * 2048 + col0 + bj * 128) = (u32x2){w0, w1};
                    } else {
                        if (fn == 1) { v0 = silu4(v0); v1 = silu4(v1); }
                        *(u32x4*)(rowp + bj * 128) = pack8(v0, v1); } } }
    }
};

template <int MODE> struct EpiMix {
    static constexpr bool PERM = true;
    const unsigned char* gt; bf16_t* mix;
    __device__ __forceinline__ void operator()(const Acc& acc, const pg8::Unit& u, int wr, int wc, int fr, int fq) const {
        const int col0 = u.pn * 256 + wc * 32 + 8 * fq;
        const size_t row0 = (size_t)(u.pm * 256 + wr * 64 + fr);
        u32x2 g[2][4]; u32x4 p[2][4];
#define EMIX_ISSUE(q, s_) do { _Pragma("unroll") for (int mm = 0; mm < 2; ++mm) _Pragma("unroll") for (int bj = 0; bj < 2; ++bj) { \
            const size_t row = row0 + ((q) >> 1) * 128 + (2 * ((q) & 1) + mm) * 16; \
            g[s_][mm * 2 + bj] = *(const u32x2*)(gt + row * 2048 + MODE * 1024 + col0 + bj * 128); \
            if (MODE == 1) p[s_][mm * 2 + bj] = *(const u32x4*)(mix + row * 1024 + col0 + bj * 128); } } while (0)
        EMIX_ISSUE(0, 0); EMIX_ISSUE(1, 1);
#pragma unroll
        for (int q = 0; q < 4; ++q) { const int s_ = q & 1, ai = q >> 1;
#pragma unroll
            for (int mm = 0; mm < 2; ++mm)
#pragma unroll
                for (int bj = 0; bj < 2; ++bj) { const int m = 2 * (q & 1) + mm; const size_t row = row0 + ai * 128 + m * 16;
                    const u32x2 gg = g[s_][mm * 2 + bj]; const float q8 = 1.f / 255.f;
                    f32x4 v0 = acc[ai][bj][m][0] * q8, v1 = acc[ai][bj][m][1] * q8;
                    v0 = (f32x4){v0[0] * (float)(gg.x & 0xffu), v0[1] * (float)((gg.x >> 8) & 0xffu), v0[2] * (float)((gg.x >> 16) & 0xffu), v0[3] * (float)(gg.x >> 24)};
                    v1 = (f32x4){v1[0] * (float)(gg.y & 0xffu), v1[1] * (float)((gg.y >> 8) & 0xffu), v1[2] * (float)((gg.y >> 16) & 0xffu), v1[3] * (float)(gg.y >> 24)};
                    if (MODE == 1) { const u32x4 pp = p[s_][mm * 2 + bj];
                        v0 += (f32x4){bflo(pp.x), bfhi(pp.x), bflo(pp.y), bfhi(pp.y)}; v1 += (f32x4){bflo(pp.z), bfhi(pp.z), bflo(pp.w), bfhi(pp.w)}; }
                    *(u32x4*)(mix + row * 1024 + col0 + bj * 128) = pack8(v0, v1); }
            if (q == 0) EMIX_ISSUE(2, 0);
            if (q == 1) EMIX_ISSUE(3, 1);
        }
#undef EMIX_ISSUE
    }
};

struct EpiX1 {
    static constexpr bool PERM = false;
    const float* x; const float* g1; float* x1;
    __device__ __forceinline__ void operator()(const Acc& acc, const pg8::Unit& u, int wr, int wc, int fr, int fq) const {
        const int col0 = u.pn * 256 + wc * 32 + 4 * fq; const int b = u.pm >> 5;
        const size_t row0 = (size_t)(u.pm * 256 + wr * 64 + fr);
        f32x4 xv[2][8], gv[2];
#define EX1_ISSUE(q, s_) do { const int c_ = col0 + ((q) >> 1) * 128 + ((q) & 1) * 16; gv[s_] = *(const f32x4*)(g1 + b * 6144 + c_); \
            _Pragma("unroll") for (int ai = 0; ai < 2; ++ai) _Pragma("unroll") for (int m = 0; m < 4; ++m) xv[s_][ai * 4 + m] = *(const f32x4*)(x + (row0 + ai * 128 + m * 16) * 1024 + c_); } while (0)
        EX1_ISSUE(0, 0); EX1_ISSUE(1, 1);
#pragma unroll
        for (int q = 0; q < 4; ++q) { const int s_ = q & 1, bj = q >> 1, n = q & 1; const int c = col0 + bj * 128 + n * 16;
#pragma unroll
            for (int ai = 0; ai < 2; ++ai)
#pragma unroll
                for (int m = 0; m < 4; ++m) *(f32x4*)(x1 + (row0 + ai * 128 + m * 16) * 1024 + c) = xv[s_][ai * 4 + m] + gv[s_] * acc[ai][bj][m][n];
            if (q == 0) EX1_ISSUE(2, 0);
            if (q == 1) EX1_ISSUE(3, 1);
        }
#undef EX1_ISSUE
    }
};

struct EpiAct {
    static constexpr bool PERM = true;
    const float* bg; const float* bu; unsigned char* act;
    __device__ __forceinline__ void operator()(const Acc& acc, const pg8::Unit& u, int wr, int wc, int fr, int fq) const {
        const int col0 = u.pn * 128 + wc * 32 + 8 * fq; const float ws_ = 1.f / 32.f;
        const f32x4 g0 = *(const f32x4*)(bg + u.e * 1024 + col0), g1 = *(const f32x4*)(bg + u.e * 1024 + col0 + 4);
        const f32x4 u0 = *(const f32x4*)(bu + u.e * 1024 + col0), u1 = *(const f32x4*)(bu + u.e * 1024 + col0 + 4);
#pragma unroll
        for (int ai = 0; ai < 2; ++ai)
#pragma unroll
            for (int m = 0; m < 4; ++m) { const size_t row = (size_t)u.pm * 256 + ai * 128 + wr * 64 + m * 16 + fr;
                f32x4 a0, a1;
#pragma unroll
                for (int j = 0; j < 4; ++j) {
                    float g = fminf(acc[ai][0][m][0][j] * ws_ + g0[j], 7.f), uu = fminf(fmaxf(acc[ai][1][m][0][j] * ws_ + u0[j], -7.f), 7.f);
                    a0[j] = g * sigm(1.702f * g) * (uu + 1.f);
                    g = fminf(acc[ai][0][m][1][j] * ws_ + g1[j], 7.f); uu = fminf(fmaxf(acc[ai][1][m][1][j] * ws_ + u1[j], -7.f), 7.f);
                    a1[j] = g * sigm(1.702f * g) * (uu + 1.f);
                }
                int w0 = 0, w1 = 0;
                w0 = __builtin_amdgcn_cvt_pk_fp8_f32(a0[0], a0[1], w0, false); w0 = __builtin_amdgcn_cvt_pk_fp8_f32(a0[2], a0[3], w0, true);
                w1 = __builtin_amdgcn_cvt_pk_fp8_f32(a1[0], a1[1], w1, false); w1 = __builtin_amdgcn_cvt_pk_fp8_f32(a1[2], a1[3], w1, true);
                *(u32x2*)(act + row * 1024 + col0) = (u32x2){(unsigned)w0, (unsigned)w1}; }
    }
};

struct EpiDown {
    static constexpr bool PERM = true;
    const float* bd; unsigned char* y; int blk0;
    __device__ __forceinline__ void operator()(const Acc& acc, const pg8::Unit& u, int wr, int wc, int fr, int fq) const {
        const int col0 = u.pn * 256 + wc * 32 + 8 * fq;
#pragma unroll
        for (int bj = 0; bj < 2; ++bj) { const int c = col0 + bj * 128;
            const f32x4 b0 = *(const f32x4*)(bd + u.e * 1024 + c), b1 = *(const f32x4*)(bd + u.e * 1024 + c + 4);
#pragma unroll
            for (int ai = 0; ai < 2; ++ai)
#pragma unroll
                for (int m = 0; m < 4; ++m) { const size_t row = (size_t)(u.pm - blk0) * 256 + ai * 128 + wr * 64 + m * 16 + fr;
                    const f32x4 v0 = acc[ai][bj][m][0] * (1.f / 32.f) + b0, v1 = acc[ai][bj][m][1] * (1.f / 32.f) + b1; int w0 = 0, w1 = 0;
                    w0 = __builtin_amdgcn_cvt_pk_fp8_f32(v0[0], v0[1], w0, false); w0 = __builtin_amdgcn_cvt_pk_fp8_f32(v0[2], v0[3], w0, true);
                    w1 = __builtin_amdgcn_cvt_pk_fp8_f32(v1[0], v1[1], w1, false); w1 = __builtin_amdgcn_cvt_pk_fp8_f32(v1[2], v1[3], w1, true);
                    *(u32x2*)(y + row * 1024 + c) = (u32x2){(unsigned)w0, (unsigned)w1}; } }
    }
};

__device__ __forceinline__ const float* ldptr(LAS unsigned char* lds, int k) {
    const unsigned long long v = ((const LAS unsigned long long*)(lds + LDS_PTAB))[k];
    const unsigned lo = __builtin_amdgcn_readfirstlane((unsigned)v), hi = __builtin_amdgcn_readfirstlane((unsigned)(v >> 32));
    typedef const __attribute__((address_space(1))) float* gptr_t;
    return (const float*)(gptr_t)(((unsigned long long)hi << 32) | lo); }
#define INP(name, k) const float* name = ldptr(lds, k)
__device__ __forceinline__ int fresh_tid() { int t = threadIdx.x; asm volatile("" : "+v"(t)); return t; }
#define LDS_BARRIER() do { asm volatile("s_waitcnt lgkmcnt(0)" ::: "memory"); __builtin_amdgcn_s_barrier(); asm volatile("" ::: "memory"); } while (0)
#define PHASE_IDS const int tid = fresh_tid(); const int lane = tid & 63, wave = __builtin_amdgcn_readfirstlane(tid >> 6); const int gw = vcu * NWAVES + wave; LAS float* scr = (LAS float*)(lds + wave * 16384); (void)lane; (void)gw; (void)scr;

#define XB_TMO      128
#define XB_XCNT(j)  (256  + 64 * (j))
#define XB_XSUB(j)  (1280 + 64 * (j))
#define XB_XGEN(j)  (2304 + 64 * (j))
#define XB_TOP      3328
#define XB_TOPGEN   3392
#define XCD_BAR_WORDS 3456
#define XB_SPIN_CAP (1u << 20)
__device__ __forceinline__ unsigned xb_ld(unsigned* p)              { return __hip_atomic_load(p, __ATOMIC_RELAXED, __HIP_MEMORY_SCOPE_AGENT); }
__device__ __forceinline__ unsigned xb_add(unsigned* p, unsigned v) { return __hip_atomic_fetch_add(p, v, __ATOMIC_RELAXED, __HIP_MEMORY_SCOPE_AGENT); }
__device__ __forceinline__ unsigned xb_xcc_id() { return (unsigned)__builtin_amdgcn_s_getreg((3 << 11) | 20) & 0xFu; }
#define XB_SPIN(cond, bar) do { unsigned _sp = 0; while (cond) { __builtin_amdgcn_s_sleep(1); \
    if ((++_sp & 255u) == 0u) { if (xb_ld(&(bar)[XB_TMO])) break; if (_sp > XB_SPIN_CAP) { atomicAdd(&(bar)[XB_TMO], 1u); break; } } } } while (0)
struct XcdBarrier { unsigned* bar; unsigned x; volatile LAS unsigned* st; };
__device__ __forceinline__ XcdBarrier xcd_barrier_post(unsigned* bar, volatile LAS unsigned* st) {
    XcdBarrier b; b.bar = bar; b.x = xb_xcc_id(); b.st = st;
    if (threadIdx.x == 0) (void)xb_add(&bar[XB_XCNT(b.x)], 1u);
    return b;
}
__device__ __forceinline__ void xcd_barrier_complete(unsigned* bar, unsigned x, unsigned& nloc, unsigned& nx) {
    const unsigned G = gridDim.x * gridDim.y * gridDim.z;
    unsigned sum, cnt, mine, sp = 0u;
    for (;;) {
        sum = 0u; cnt = 0u; mine = 0u;
#pragma unroll
        for (unsigned j = 0; j < 16; ++j) { const unsigned c = xb_ld(&bar[XB_XCNT(j)]); sum += c; cnt += (c > 0u) ? 1u : 0u; mine = (j == x) ? c : mine; }
        if (sum == G) break;
        __builtin_amdgcn_s_sleep(1);
        if ((++sp & 255u) == 0u) { if (xb_ld(&bar[XB_TMO])) break; if (sp > XB_SPIN_CAP) { atomicAdd(&bar[XB_TMO], 1u); break; } }
    }
    nloc = mine > 0u ? mine : 1u; nx = cnt > 0u ? cnt : 1u;
}
__device__ __forceinline__ void xcd_barrier(const XcdBarrier& b) {
    asm volatile("s_waitcnt vmcnt(0)" ::: "memory");
    __syncthreads();
    if (threadIdx.x == 0) {
        unsigned* bar = b.bar;
        __builtin_amdgcn_s_waitcnt(0);
        unsigned nloc = b.st[0], nx = b.st[1];
        if (nloc == 0u) { xcd_barrier_complete(bar, b.x, nloc, nx); b.st[0] = nloc; b.st[1] = nx; }
        const unsigned old = xb_add(&bar[XB_XSUB(b.x)], 1u);
        const unsigned gen = old / nloc;
        if (old + 1u == (gen + 1u) * nloc) {
            __builtin_amdgcn_fence(__ATOMIC_RELEASE, "agent");
            asm volatile("s_waitcnt vmcnt(0)" ::: "memory");
            const unsigned og = xb_add(&bar[XB_TOP], 1u);
            const unsigned tg = og / nx;
            if (og + 1u == (tg + 1u) * nx) xb_add(&bar[XB_TOPGEN], 1u);
            else XB_SPIN(xb_ld(&bar[XB_TOPGEN]) == tg, bar);
            __builtin_amdgcn_fence(__ATOMIC_ACQUIRE, "agent");
            xb_add(&bar[XB_XGEN(b.x)], 1u);
            asm volatile("s_waitcnt vmcnt(0)" ::: "memory");
        } else {
            XB_SPIN(xb_ld(&bar[XB_XGEN(b.x)]) == gen, bar);
            __builtin_amdgcn_fence(__ATOMIC_ACQUIRE, "agent");
            asm volatile("s_waitcnt vmcnt(0)" ::: "memory");
        }
    }
    __syncthreads();
}
struct Args {
    const float* in[23]; float* out; unsigned char* ws;
};

struct CvItem { const float* src; bf16_t* dst; int ldw, K, ncols; float f8scale; };
__device__ __forceinline__ void cv_load(f32x4 (&v)[8], const CvItem& c, int lane) {
    const int kk0 = lane >> 3, cq = lane & 7;
#pragma unroll
    for (int i = 0; i < 8; ++i) v[i] = (4 * cq < c.ncols) ? *(const f32x4*)(c.src + (size_t)(kk0 + 8 * i) * c.ldw + 4 * cq) : (f32x4){0.f, 0.f, 0.f, 0.f};
}
template <class F> __device__ __forceinline__ void convert_items(int n_items, int gw, int NGW, LAS float* scr, int lane, F get) {
    int it = gw; if (it >= n_items) return;
    CvItem ci = get(it), ni = ci; f32x4 cur[8], nxt[8];
    cv_load(cur, ci, lane);
    const int kk0 = lane >> 3, cq = lane & 7;
    for (;;) {
        const int itn = it + NGW; const bool hn = itn < n_items;
        if (hn) { ni = get(itn); cv_load(nxt, ni, lane); }
#pragma unroll
        for (int i = 0; i < 8; ++i) { LAS float* d = scr + (kk0 + 8 * i) * 33 + 4 * cq; d[0] = cur[i][0]; d[1] = cur[i][1]; d[2] = cur[i][2]; d[3] = cur[i][3]; }
        asm volatile("s_waitcnt lgkmcnt(0)" ::: "memory");
#pragma unroll
        for (int j = 0; j < 4; ++j) { const int n = kk0 + 8 * j; const LAS float* q = scr + (8 * cq) * 33 + n;
            if (ci.f8scale != 0.f) { const float sc = ci.f8scale; int w0 = 0, w1 = 0;
                w0 = __builtin_amdgcn_cvt_pk_fp8_f32(q[0 * 33] * sc, q[1 * 33] * sc, w0, false); w0 = __builtin_amdgcn_cvt_pk_fp8_f32(q[2 * 33] * sc, q[3 * 33] * sc, w0, true);
                w1 = __builtin_amdgcn_cvt_pk_fp8_f32(q[4 * 33] * sc, q[5 * 33] * sc, w1, false); w1 = __builtin_amdgcn_cvt_pk_fp8_f32(q[6 * 33] * sc, q[7 * 33] * sc, w1, true);
                *(u32x2*)((unsigned char*)ci.dst + (size_t)n * ci.K + 8 * cq) = (u32x2){(unsigned)w0, (unsigned)w1}; }
            else { u32x4 o; o.x = pk2(q[0 * 33], q[1 * 33]); o.y = pk2(q[2 * 33], q[3 * 33]); o.z = pk2(q[4 * 33], q[5 * 33]); o.w = pk2(q[6 * 33], q[7 * 33]);
                *(u32x4*)(ci.dst + (size_t)n * ci.K + 8 * cq) = o; } }
        asm volatile("s_waitcnt lgkmcnt(0)" ::: "memory");
        if (!hn) break;
        it = itn; ci = ni;
#pragma unroll
        for (int i = 0; i < 8; ++i) cur[i] = nxt[i];
    }
}

__global__ void __launch_bounds__(NTHR, 2) mega_fwd(Args args) {
    extern __shared__ __attribute__((aligned(16))) unsigned char lds_raw[];
    LAS unsigned char* lds = (LAS unsigned char*)lds_raw;
    cg::grid_group grid = cg::this_grid();
    const int G = gridDim.x, bx = blockIdx.x;
    { volatile LAS unsigned* mz = (volatile LAS unsigned*)(lds + LDS_MISC); if (threadIdx.x < 64) mz[threadIdx.x] = 0u;
      if (threadIdx.x == 64) { LAS unsigned long long* pt = (LAS unsigned long long*)(lds + LDS_PTAB);
#pragma unroll
          for (int k = 0; k < 23; ++k) pt[k] = (unsigned long long)args.in[k]; } }
    __syncthreads();
    XcdBarrier xbar = xcd_barrier_post((unsigned*)(args.ws + WS_CTL) + CW_BAR, (volatile LAS unsigned*)(lds + LDS_MISC) + 8);
#if PROBE >= 10
    int tsn_ = 0;
#define TSTAMP() do { if (blockIdx.x == 0) ((volatile unsigned*)(args.ws + WS_CTL))[15000 + tsn_] = (unsigned)__builtin_amdgcn_s_memrealtime(); ++tsn_; } while (0)
#else
#define TSTAMP() do {} while (0)
#endif
    TSTAMP();
#define GRID_BAR() do { xcd_barrier(xbar); TSTAMP(); } while (0)
    const int vcu = (G % 8 == 0) ? (bx % 8) * (G / 8) + bx / 8 : bx;
    const int NGW = G * NWAVES;
    unsigned char* ws = args.ws;
    float* out = args.out;
#define ctl   ((unsigned*)(ws + WS_CTL))
#define modp  ((float*)(ws + WS_MODP))
#define mod   ((float*)(ws + WS_MOD))
#define tab   ((float*)(ws + WS_TAB))
#define kmean ((float*)(ws + WS_KMEAN))
#define gkl   ((float*)(ws + WS_GK))
#define topw  ((float*)(ws + WS_TOPW))
#define dest  ((int*)(ws + WS_DEST))
#define list  ((int*)(ws + WS_LIST))
#define WinT  ((bf16_t*)(ws + WS_WIN))
#define WpaT  ((bf16_t*)(ws + WS_WPA))
#define WpbT  ((bf16_t*)(ws + WS_WPB))
#define WoutT ((bf16_t*)(ws + WS_WOUT))
#define WdT   ((bf16_t*)(ws + WS_WD))
#define WguT  ((bf16_t*)(ws + WS_WGU))
#define XN    ((bf16_t*)(ws + WS_XN))
#define Qm    ((bf16_t*)(ws + WS_QM))
#define Km    ((bf16_t*)(ws + WS_KM))
#define Vm    ((bf16_t*)(ws + WS_VM))
#define QBb   ((bf16_t*)(ws + WS_QB))
#define KBb   ((bf16_t*)(ws + WS_KB))
#define VBb   ((bf16_t*)(ws + WS_VB))
#define Rb    ((bf16_t*)(ws + WS_R))
#define GT    ((bf16_t*)(ws + WS_GT))
#define MIX   ((bf16_t*)(ws + WS_MIX))
#define H2    ((bf16_t*)(ws + WS_H2))
#define ACT   ((bf16_t*)(ws + WS_ACT))
#define YA    ((bf16_t*)(ws + WS_YA))
#define YBr   ((bf16_t*)(ws + WS_ACT))
#define ya    ((bf16_t*)(ws + WS_YAW))
#define yb    ((bf16_t*)(ws + WS_YBW))
#define VT    ((bf16_t*)(ws + WS_VT))
#define PO    ((bf16_t*)out)
#define ML    ((float*)(ws + WS_ML))
#define DEC   ((float*)(ws + WS_SLOC + 8 * MiB))
#define LST   ((unsigned short*)(ws + WS_LST))

    {
        PHASE_IDS
        INP(cvec, 1); INP(rel_bias, 2); INP(w_ada, 3); INP(w_in, 6); INP(w_pa, 10); INP(w_pb, 11); INP(w_out, 12);
        {
            LAS float* ssl = scr;
            for (int it = gw; it < 24 * 16; it += NGW) {
                const int cgp = it % 24, kc = it / 24; const int col = cgp * 256 + lane * 4;
#pragma unroll
                for (int q = 0; q < 4; ++q) { const int idx = q * 64 + lane; const int bq = idx >> 6, kq = idx & 63; const float cv = cvec[bq * 1024 + kc * 64 + kq]; ssl[idx] = cv * sigm(cv); }
                asm volatile("s_waitcnt lgkmcnt(0)" ::: "memory");
                f32x4 a0 = {0.f, 0.f, 0.f, 0.f}, a1 = a0, a2 = a0, a3 = a0;
                const float* wp = w_ada + (size_t)(kc * 64) * 6144 + col;
#pragma unroll 1
                for (int k0 = 0; k0 < 64; k0 += 32) { f32x4 w[32];
#pragma unroll
                    for (int q = 0; q < 32; ++q) w[q] = *(const f32x4*)(wp + (size_t)(k0 + q) * 6144);
#pragma unroll
                    for (int q = 0; q < 32; ++q) { a0 += w[q] * ssl[k0 + q]; a1 += w[q] * ssl[64 + k0 + q]; a2 += w[q] * ssl[128 + k0 + q]; a3 += w[q] * ssl[192 + k0 + q]; } }
                float* mp = modp + (size_t)kc * (4 * 6144) + col;
                *(f32x4*)mp = a0; *(f32x4*)(mp + 6144) = a1; *(f32x4*)(mp + 2 * 6144) = a2; *(f32x4*)(mp + 3 * 6144) = a3;
                asm volatile("s_waitcnt lgkmcnt(0)" ::: "memory");
            }
        }
        if (gw == NGW - 1) {
            for (int i = lane; i < 8 * 128; i += 64) { const int h = i >> 7, n = i & 127; int bkt;
                if (n < 16) bkt = n; else { const int l = 16 + (int)(logf((float)n / 16.f) / logf(8.f) * 16.f); bkt = l < 31 ? l : 31; }
                tab[i] = rel_bias[bkt * 8 + h]; }
            if (lane < 8) tab[1024 + lane] = rel_bias[31 * 8 + lane];
        }
        {
            constexpr int I_IN = 16 * 208, I_PA = 8 * 32, I_PB = 16 * 32, I_OUT = 16 * 32;
            constexpr int NIT = I_IN + I_PA + I_PB + I_OUT;
            convert_items(NIT, gw, NGW, scr, lane, [=](int it) -> CvItem {
                int r = it;
                if (r < I_IN) { const int kb = r / 208, nb = r % 208; const int dr0 = nb * 32; const int sc0 = dr0 < 1024 ? dr0 : (dr0 < 2048 ? dr0 + 512 : (dr0 < 2560 ? dr0 - 1024 : (dr0 < 3584 ? dr0 : dr0 + 16)));
                    if (dr0 >= P2_F8_FROM * 256) return CvItem{w_in + (size_t)(kb * 64) * DIN + sc0, (bf16_t*)((unsigned char*)WinT + (size_t)(P2_F8_FROM * 256) * 2048 + (size_t)(dr0 - P2_F8_FROM * 256) * 1024 + kb * 64), DIN, 1024, 32, 32.f};
                    return CvItem{w_in + (size_t)(kb * 64) * DIN + sc0, WinT + (size_t)dr0 * 1024 + kb * 64, DIN, 1024, 32, 0.f}; } r -= I_IN;
                if (r < I_PA) { const int kb = r / 32, nb = r % 32; return CvItem{w_pa + (size_t)(kb * 64) * 1024 + nb * 32, WpaT + (size_t)(nb * 32) * 512 + kb * 64, 1024, 512, 32, 0.f}; } r -= I_PA;
                if (r < I_PB) { const int kb = r / 32, nb = r % 32; return CvItem{w_pb + (size_t)(kb * 64) * 1024 + nb * 32, WpbT + (size_t)(nb * 32) * 1024 + kb * 64, 1024, 1024, 32, 0.f}; } r -= I_PB;
                { const int kb = r / 32, nb = r % 32; return CvItem{w_out + (size_t)(kb * 64) * 1024 + nb * 32, WoutT + (size_t)(nb * 32) * 1024 + kb * 64, 1024, 1024, 32, 0.f}; }
            });
        }
    }
    if (args.ws == nullptr) grid.sync();
    GRID_BAR();

    {
        PHASE_IDS
        INP(x, 0); INP(b_ada, 4); INP(norm_mix, 5); INP(w_in, 6);
        LAS float* smod = (LAS float*)lds;
        constexpr int NKC = 16;
#pragma unroll 1
        for (int i4 = tid; i4 < 4 * 2048 / 4; i4 += NTHR) { const int b = i4 >> 9, c = (i4 & 511) * 4; f32x4 pv[NKC];
#pragma unroll
            for (int kc = 0; kc < NKC; ++kc) pv[kc] = *(const f32x4*)(modp + (size_t)kc * (4 * 6144) + b * 6144 + c);
            f32x4 a = *(const f32x4*)(b_ada + c);
#pragma unroll
            for (int kc = 0; kc < NKC; ++kc) a += pv[kc];
            *(LAS f32x4*)(smod + b * 2048 + c) = a; }
#pragma unroll 1
        for (int i4 = bx * NTHR + tid; i4 < 4 * 6144 / 4; i4 += G * NTHR) { const int c = (i4 * 4) % 6144; f32x4 pv[NKC];
#pragma unroll
            for (int kc = 0; kc < NKC; ++kc) pv[kc] = *(const f32x4*)(modp + (size_t)kc * (4 * 6144) + i4 * 4);
            f32x4 a = *(const f32x4*)(b_ada + c);
#pragma unroll
            for (int kc = 0; kc < NKC; ++kc) a += pv[kc];
            *(f32x4*)(mod + i4 * 4) = a; }
        LAS f32x4* wgl = (LAS f32x4*)(lds + 32768);
#pragma unroll
        for (int q = 0; q < 8; ++q) { const int idx = q * NTHR + tid, k = idx >> 2, o4 = idx & 3;
            wgl[(((k >> 8) * 4 + (k & 3)) * 4 + o4) * 64 + ((k >> 2) & 63)] = *(const f32x4*)(w_in + (size_t)k * DIN + 3584 + 4 * o4); }
        __syncthreads();
        f32x4 xn_[4], nmw[4];
#pragma unroll
        for (int j = 0; j < 4; ++j) nmw[j] = *(const f32x4*)(norm_mix + 256 * j + 4 * lane);
        { const f32x4* xr = (const f32x4*)(x + (size_t)gw * DM) + lane;
#pragma unroll
          for (int j = 0; j < 4; ++j) xn_[j] = (gw < TT) ? xr[64 * j] : (f32x4){0.f, 0.f, 0.f, 0.f}; }
        auto p1row = [&](int m) __attribute__((always_inline)) {
            const int b = m >> 13;
            f32x4 v[4]; float s = 0.f;
#pragma unroll
            for (int j = 0; j < 4; ++j) { v[j] = xn_[j]; s += (v[j][0] * v[j][0] + v[j][1] * v[j][1]) + (v[j][2] * v[j][2] + v[j][3] * v[j][3]); }
            { const int mn = (m + NGW < TT) ? m + NGW : m; const f32x4* xr = (const f32x4*)(x + (size_t)mn * DM) + lane;
#pragma unroll
                for (int j = 0; j < 4; ++j) xn_[j] = xr[64 * j]; }
            const float rs = rsqrtf(wave_sum(s) * (1.f / DM) + 1e-6f);
            unsigned long long* o8 = (unsigned long long*)(XN + (size_t)m * DM) + lane; unsigned* o4 = (unsigned*)(ws + WS_XN8 + (size_t)m * DM) + lane;
#pragma unroll
            for (int j = 0; j < 4; ++j) { const int c = 256 * j + 4 * lane;
                const f32x4 w = nmw[j]; const f32x4 sh = *(const LAS f32x4*)(smod + b * 2048 + c), sc = *(const LAS f32x4*)(smod + b * 2048 + 1024 + c);
                const f32x4 h = (v[j] * rs) * w * (sc + 1.f) + sh; v[j] = h;
                o8[64 * j] = (unsigned long long)pk2(h[0], h[1]) | ((unsigned long long)pk2(h[2], h[3]) << 32);
                int w8 = 0; w8 = __builtin_amdgcn_cvt_pk_fp8_f32(h[0], h[1], w8, false); w8 = __builtin_amdgcn_cvt_pk_fp8_f32(h[2], h[3], w8, true); o4[64 * j] = (unsigned)w8; }
            f32x4 ga[4];
#pragma unroll
            for (int o4 = 0; o4 < 4; ++o4) ga[o4] = (f32x4){0.f, 0.f, 0.f, 0.f};
#pragma unroll
            for (int j = 0; j < 4; ++j) {
#pragma unroll
                for (int i = 0; i < 4; ++i)
#pragma unroll
                    for (int o4 = 0; o4 < 4; ++o4) ga[o4] += wgl[((j * 4 + i) * 4 + o4) * 64 + lane] * v[j][i];
                __builtin_amdgcn_sched_barrier(0); }
            float r8[8], r4[4], r2[2], g1;
            { const bool hi = (lane & 32) != 0;
#pragma unroll
              for (int q = 0; q < 8; ++q) { const float a = ga[q >> 2][q & 3], bq_ = ga[2 + (q >> 2)][q & 3]; const float mine = hi ? bq_ : a, oth = hi ? a : bq_; r8[q] = mine + __shfl_xor(oth, 32); } }
            { const bool hi = (lane & 16) != 0;
#pragma unroll
              for (int q = 0; q < 4; ++q) { const float mine = hi ? r8[q + 4] : r8[q], oth = hi ? r8[q] : r8[q + 4]; r4[q] = mine + __shfl_xor(oth, 16); } }
            { const bool hi = (lane & 8) != 0;
#pragma unroll
              for (int q = 0; q < 2; ++q) { const float mine = hi ? r4[q + 2] : r4[q], oth = hi ? r4[q] : r4[q + 2]; r2[q] = mine + __shfl_xor(oth, 8); } }
            { const bool hi = (lane & 4) != 0; const float mine = hi ? r2[1] : r2[0], oth = hi ? r2[0] : r2[1]; g1 = mine + __shfl_xor(oth, 4); }
            g1 += __shfl_xor(g1, 2); g1 += __shfl_xor(g1, 1);
            gkl[(size_t)m * 16 + (lane >> 2)] = g1;
        };
        p1row(gw);
        for (int m = gw + NGW; m < TT; m += NGW) p1row(m);
    }
    GRID_BAR();

    {
        { pg8::DenseOrder S; S.init(TT, P2_F8_FROM * 256, G, bx, XN, 1024, WinT, 1024); S.reps = REPN(1);
          EpiProj E{ws, 0, 1.f};
          pg8::gemm_phase<EpiProj, pg8::DenseOrder, false, 1024, 1024, 16>(lds, S, E); }
        { pg8::DenseOrder S; S.init(TT, NPROJ - P2_F8_FROM * 256, G, bx, ws + WS_XN8, 512, (unsigned char*)WinT + (size_t)(P2_F8_FROM * 256) * 2048, 512); S.reps = REPN(1);
          EpiProj E{ws, P2_F8_FROM, 1.f / 32.f};
          pg8::gemm_phase<EpiProj, pg8::DenseOrder, false, 512, 512, 8, true>(lds, S, E); }
    }
    GRID_BAR();

    {
    PHASE_IDS
    for (int it = gw; it < 32 * 32; it += NGW) {
        const int bh = it >> 5, n = it & 31, b = bh >> 3, h = bh & 7, rg = lane >> 3, dc = lane & 7;
        const bf16_t* kp = Km + (size_t)(b * SEQ + n * 256 + rg) * 512 + h * 64 + dc * 8;
        float a[8];
#pragma unroll
        for (int q = 0; q < 8; ++q) a[q] = 0.f;
#pragma unroll 8
        for (int i = 0; i < 32; ++i) { const u32x4 v = *(const u32x4*)(kp + (size_t)i * 8 * 512);
            a[0] += bflo(v.x); a[1] += bfhi(v.x); a[2] += bflo(v.y); a[3] += bfhi(v.y); a[4] += bflo(v.z); a[5] += bfhi(v.z); a[6] += bflo(v.w); a[7] += bfhi(v.w); }
#pragma unroll
        for (int q = 0; q < 8; ++q) { a[q] += __shfl_xor(a[q], 8); a[q] += __shfl_xor(a[q], 16); a[q] += __shfl_xor(a[q], 32); }
        if (rg == 0) { float* kd = kmean + (size_t)it * 64 + dc * 8; const float sc = 1.f / 256.f;
            *(f32x4*)kd = (f32x4){a[0] * sc, a[1] * sc, a[2] * sc, a[3] * sc}; *(f32x4*)(kd + 4) = (f32x4){a[4] * sc, a[5] * sc, a[6] * sc, a[7] * sc}; }
    }
    {
        LAS unsigned short* tl = (LAS unsigned short*)(lds + wave * 16384);
        for (int it = gw; it < 32 * 128; it += NGW) {
            const int bh = it >> 7, tt = it & 127, b = bh >> 3, h = bh & 7;
            const u32x4* vr = (const u32x4*)(Vm + (size_t)(b * SEQ + tt * 64 + lane) * 512 + h * 64);
#pragma unroll
            for (int c8 = 0; c8 < 8; ++c8) { const u32x4 v = vr[c8];
                tl[(c8 * 8 + 0) * 72 + lane] = (unsigned short)(v.x & 0xffff); tl[(c8 * 8 + 1) * 72 + lane] = (unsigned short)(v.x >> 16);
                tl[(c8 * 8 + 2) * 72 + lane] = (unsigned short)(v.y & 0xffff); tl[(c8 * 8 + 3) * 72 + lane] = (unsigned short)(v.y >> 16);
                tl[(c8 * 8 + 4) * 72 + lane] = (unsigned short)(v.z & 0xffff); tl[(c8 * 8 + 5) * 72 + lane] = (unsigned short)(v.z >> 16);
                tl[(c8 * 8 + 6) * 72 + lane] = (unsigned short)(v.w & 0xffff); tl[(c8 * 8 + 7) * 72 + lane] = (unsigned short)(v.w >> 16); }
            asm volatile("s_waitcnt lgkmcnt(0)" ::: "memory");
            u32x4* dst = (u32x4*)(VT + ((size_t)bh * 64 + lane) * 8192 + tt * 64);
#pragma unroll
            for (int c8 = 0; c8 < 8; ++c8) dst[c8] = *(const LAS u32x4*)(tl + lane * 72 + c8 * 8);
            asm volatile("s_waitcnt lgkmcnt(0)" ::: "memory");
        }
    }
    }

    {
        PHASE_IDS
        INP(w_gk_up, 7); INP(b_gk, 8);
        LAS float* gks = (LAS float*)(lds + wave * 16384 + 10240);
        const int d0 = 2 * lane;
        for (int it = gw; it < 16 * 128; it += NGW) {
            const int bhh = it >> 7, n = it & 127, b = bhh >> 2, h = bhh & 3;
            const size_t t0 = (size_t)b * SEQ + (size_t)n * 64;
            f32x2_t w01[16];
#pragma unroll
            for (int q = 0; q < 16; ++q) w01[q] = *(const f32x2_t*)(w_gk_up + q * 512 + h * 128 + d0);
            const f32x2_t bias01 = *(const f32x2_t*)(b_gk + h * 128 + d0);
            { const f32x4* gp = (const f32x4*)(gkl + (t0 + lane) * 16);
#pragma unroll
              for (int q = 0; q < 4; ++q) *(LAS f32x4*)(gks + lane * 16 + 4 * q) = gp[q]; }
            asm volatile("s_waitcnt lgkmcnt(0)" ::: "memory");
            f32x2_t run2 = {0.f, 0.f};
            const bf16_t* qrow = QBb + t0 * 512 + h * 128 + d0; const bf16_t* krow = KBb + t0 * 512 + h * 128 + d0;
#pragma unroll 1
            for (int c0 = 0; c0 < 64; c0 += 16) {
                unsigned qv[16], kv[16];
#pragma unroll
                for (int i = 0; i < 16; ++i) { qv[i] = *(const unsigned*)(qrow + (size_t)(c0 + i) * 512); kv[i] = *(const unsigned*)(krow + (size_t)(c0 + i) * 512); }
#pragma unroll
                for (int i = 0; i < 16; ++i) { const LAS f32x4* gp = (const LAS f32x4*)(gks + (c0 + i) * 16); f32x2_t s2 = bias01;
#pragma unroll
                    for (int q4 = 0; q4 < 4; ++q4) { const f32x4 g4 = gp[q4];
                        s2 += w01[4 * q4] * g4[0]; s2 += w01[4 * q4 + 1] * g4[1]; s2 += w01[4 * q4 + 2] * g4[2]; s2 += w01[4 * q4 + 3] * g4[3]; }
                    const float L2E = 1.4426950408889634f;
                    const float l0 = fminf(s2[0], 0.f) * L2E - __builtin_amdgcn_logf(1.f + __builtin_amdgcn_exp2f(-fabsf(s2[0]) * L2E));
                    const float l1 = fminf(s2[1], 0.f) * L2E - __builtin_amdgcn_logf(1.f + __builtin_amdgcn_exp2f(-fabsf(s2[1]) * L2E));
                    run2[0] += l0 * (1.f / 16.f); run2[1] += l1 * (1.f / 16.f);
                    *(unsigned*)(const_cast<bf16_t*>(qrow) + (size_t)(c0 + i) * 512) = cvtpk(bflo(qv[i]) * __builtin_amdgcn_exp2f(run2[0]), bfhi(qv[i]) * __builtin_amdgcn_exp2f(run2[1]));
                    *(unsigned*)(const_cast<bf16_t*>(krow) + (size_t)(c0 + i) * 512) = cvtpk(bflo(kv[i]) * __builtin_amdgcn_exp2f(-run2[0]), bfhi(kv[i]) * __builtin_amdgcn_exp2f(-run2[1])); }
            }
            { float* dc = DEC + ((size_t)bhh * 128 + n) * 128 + d0; dc[0] = __builtin_amdgcn_exp2f(run2[0]); dc[1] = __builtin_amdgcn_exp2f(run2[1]); }
            asm volatile("s_waitcnt lgkmcnt(0)" ::: "memory");
        }
    }
    GRID_BAR();

    {
        PHASE_IDS
        LAS unsigned* ebuf = (LAS unsigned*)(lds + 32768);
        LAS int* lcn = (LAS int*)(lds + 32768 + 12288);
        const int r = lane & 31, hf = lane >> 5;
        for (int wgi = vcu; wgi < 256; wgi += G) {
            const int bh = wgi >> 3, tq0 = (wgi & 7) * 1024, b = bh >> 3, h = bh & 7;
            __syncthreads();
            if (tid < 64) lcn[tid] = 0;
            bf16x8 ah[4], al[4];
            { const float* kp = kmean + ((size_t)bh * 32 + r) * 64 + 8 * hf;
#pragma unroll
              for (int s4 = 0; s4 < 4; ++s4) { const f32x4 k0 = *(const f32x4*)(kp + 16 * s4), k1 = *(const f32x4*)(kp + 16 * s4 + 4);
                  const float kv[8] = {k0[0], k0[1], k0[2], k0[3], k1[0], k1[1], k1[2], k1[3]}; unsigned hw[4], lw[4];
#pragma unroll
                  for (int q = 0; q < 4; ++q) { const unsigned h0 = f2bf(kv[2 * q]), h1 = f2bf(kv[2 * q + 1]);
                      hw[q] = h0 | (h1 << 16); lw[q] = pk2(kv[2 * q] - __builtin_bit_cast(float, h0 << 16), kv[2 * q + 1] - __builtin_bit_cast(float, h1 << 16)); }
                  ah[s4] = __builtin_bit_cast(bf16x8, (u32x4){hw[0], hw[1], hw[2], hw[3]}); al[s4] = __builtin_bit_cast(bf16x8, (u32x4){lw[0], lw[1], lw[2], lw[3]}); } }
            __syncthreads();
            bf16x8 bq[4], bqn[4];
            { const bf16_t* qp = Qm + (size_t)(b * SEQ + tq0 + wave * 128 + r) * 512 + h * 64 + 8 * hf;
#pragma unroll
              for (int s4 = 0; s4 < 4; ++s4) { bq[s4] = *(const bf16x8*)(qp + 16 * s4); bqn[s4] = bq[s4]; } }
#pragma unroll 1
            for (int g = 0; g < 4; ++g) {
                const int t = tq0 + wave * 128 + g * 32 + r, j = t >> 8;
                if (g < 3) { const bf16_t* qp = Qm + (size_t)(b * SEQ + t + 32) * 512 + h * 64 + 8 * hf;
#pragma unroll
                    for (int s4 = 0; s4 < 4; ++s4) bqn[s4] = *(const bf16x8*)(qp + 16 * s4); }
                if (j > 0) {
                    f32x16 gt;
#pragma unroll
                    for (int i = 0; i < 16; ++i) gt[i] = 0.f;
#pragma unroll
                    for (int s4 = 0; s4 < 4; ++s4) { gt = __builtin_amdgcn_mfma_f32_32x32x16_bf16(ah[s4], bq[s4], gt, 0, 0, 0); gt = __builtin_amdgcn_mfma_f32_32x32x16_bf16(al[s4], bq[s4], gt, 0, 0, 0); }
#pragma unroll
                    for (int i = 0; i < 16; ++i) gt[i] = (crow(i, hf) < j) ? gt[i] : -INFINITY;
                    const int nsel = j < 3 ? j : 3;
                    int sel[3];
#pragma unroll
                    for (int p = 0; p < 3; ++p) { float best = -INFINITY; int bi = 4 * hf;
#pragma unroll
                        for (int i = 0; i < 16; ++i) if (gt[i] > best) { best = gt[i]; bi = crow(i, hf); }
                        const float ob = __shfl_xor(best, 32); const int oi = __shfl_xor(bi, 32);
                        if (ob > best || (ob == best && oi < bi)) { best = ob; bi = oi; }
                        sel[p] = bi;
#pragma unroll
                        for (int i = 0; i < 16; ++i) gt[i] = (crow(i, hf) == bi) ? -INFINITY : gt[i]; }
                    if (hf == 0) {
#pragma unroll
                        for (int p = 0; p < 3; ++p) if (p < nsel) { const int n = sel[p];
                            const int lpos = __hip_atomic_fetch_add(lcn + n, 1, __ATOMIC_RELAXED, __HIP_MEMORY_SCOPE_WORKGROUP);
                            const int ei = __hip_atomic_fetch_add(lcn + 32, 1, __ATOMIC_RELAXED, __HIP_MEMORY_SCOPE_WORKGROUP);
                            ebuf[ei] = ((unsigned)n << 26) | ((unsigned)lpos << 15) | (unsigned)((t << 2) | p); } }
                }
#pragma unroll
                for (int s4 = 0; s4 < 4; ++s4) bq[s4] = bqn[s4];
            }
            asm volatile("s_waitcnt lgkmcnt(0)" ::: "memory");
            __syncthreads();
            if (tid < 32) { const int c = lcn[tid]; lcn[64 + tid] = c ? (int)atomicAdd(&ctl[CW_LCNT + bh * 32 + tid], (unsigned)c) : 0; }
            __syncthreads();
            { const int ne = lcn[32];
              for (int i = tid; i < ne; i += NTHR) { const unsigned e = ebuf[i]; const int n = (int)(e >> 26), lpos = (int)((e >> 15) & 2047u);
                  LST[(size_t)bh * LST_STRIDE + 256 * (31 * n - (n * (n - 1)) / 2) + lcn[64 + n] + lpos] = (unsigned short)(e & 32767u); } }
        }
        if (GLA_NSPLIT == 2 && gw < 32) {
            const int bh4 = gw >> 1, d = (gw & 1) * 64 + lane; const float* dg = DEC + ((size_t)bh4 * 128 + 64) * 128 + d; float* pnp = (float*)(ws + WS_PN) + (size_t)bh4 * 64 * 128 + d;
            float p = 1.f;
#pragma unroll 1
            for (int n0 = 0; n0 < 64; n0 += 16) { float dv[16];
#pragma unroll
                for (int q = 0; q < 16; ++q) dv[q] = dg[(size_t)(n0 + q) * 128];
#pragma unroll
                for (int q = 0; q < 16; ++q) { pnp[(size_t)(n0 + q) * 128] = p; p *= dv[q]; } }
        }
    }
    GRID_BAR();

    for (int rep_ = 0; rep_ < REPN(2); ++rep_) {
    if (bx < 64 * GLA_NSPLIT) for (int rg_ = 0; rg_ < REPN(6); ++rg_) {
        PHASE_IDS
        const int seg = bx >> 6, b = (bx >> 4) & 3, h = (bx >> 2) & 3, es = bx & 3, n0 = seg * GLA_CPS;
        LAS unsigned char* Qg = lds;
        LAS unsigned char* Kg = lds + 17408;
        LAS unsigned char* KgT = lds + 34816;
        LAS unsigned char* VTl = lds + 53248;
        LAS unsigned char* STl = lds + 62464;
        LAS float* decl = (LAS float*)(lds + 79872);
        const int dp = tid & 63, c8 = wave, d0 = 2 * dp;
        const int r = lane & 31, hf = lane >> 5;
        for (int i = tid; i < 17408 / 4; i += NTHR) ((LAS unsigned*)STl)[i] = 0u;
        f32x16 sacc;
#pragma unroll
        for (int i = 0; i < 16; ++i) sacc[i] = 0.f;
        const int sdt = wave >> 1, set_ = wave & 1;
        const size_t tok0 = (size_t)b * SEQ;
        const float* decg = DEC + (size_t)(b * 4 + h) * 128 * 128;
        unsigned qrA[8], krA[8], qrB[8], krB[8], vrA[4], vrB[4]; float drA = 0.f, drB = 0.f;
        const int ep2 = (tid & 31) * 2, c16 = tid >> 5;
#define GLA_LOAD(n_, qr, kr, vr, dr) do { const size_t t0_ = tok0 + (size_t)(n_) * 64; \
            _Pragma("unroll") for (int i = 0; i < 8; ++i) { const size_t row_ = t0_ + c8 * 8 + i; \
                qr[i] = *(const unsigned*)(QBb + row_ * 512 + h * 128 + d0); kr[i] = *(const unsigned*)(KBb + row_ * 512 + h * 128 + d0); } \
            _Pragma("unroll") for (int i = 0; i < 4; ++i) vr[i] = *(const unsigned*)(VBb + (t0_ + c16 * 4 + i) * 1024 + h * 256 + es * 64 + ep2); \
            if (tid < 128) dr = decg[(size_t)(n_) * 128 + tid]; } while (0)
#define GLA_STAGE(qr, kr, vr, dr) do { \
            _Pragma("unroll") for (int i = 0; i < 8; ++i) { const int c = c8 * 8 + i; *(LAS unsigned*)(Qg + c * 272 + d0 * 2) = qr[i]; *(LAS unsigned*)(Kg + c * 272 + d0 * 2) = kr[i]; } \
            { u32x4 k0, k1; \
              k0.x = (kr[0] & 0xffffu) | (kr[1] << 16); k0.y = (kr[2] & 0xffffu) | (kr[3] << 16); k0.z = (kr[4] & 0xffffu) | (kr[5] << 16); k0.w = (kr[6] & 0xffffu) | (kr[7] << 16); \
              k1.x = (kr[0] >> 16) | (kr[1] & 0xffff0000u); k1.y = (kr[2] >> 16) | (kr[3] & 0xffff0000u); k1.z = (kr[4] >> 16) | (kr[5] & 0xffff0000u); k1.w = (kr[6] >> 16) | (kr[7] & 0xffff0000u); \
              *(LAS u32x4*)(KgT + d0 * 144 + c8 * 16) = k0; *(LAS u32x4*)(KgT + (d0 + 1) * 144 + c8 * 16) = k1; \
              *(LAS u32x2*)(VTl + ep2 * 144 + c16 * 8) = (u32x2){(vr[0] & 0xffffu) | (vr[1] << 16), (vr[2] & 0xffffu) | (vr[3] << 16)}; \
              *(LAS u32x2*)(VTl + (ep2 + 1) * 144 + c16 * 8) = (u32x2){(vr[0] >> 16) | (vr[1] & 0xffff0000u), (vr[2] >> 16) | (vr[3] & 0xffff0000u)}; } \
            if (tid < 128) decl[tid] = dr; } while (0)
        GLA_LOAD(n0, qrA, krA, vrA, drA);
        GLA_LOAD(n0 + 1, qrB, krB, vrB, drB);
#define GLA_OBODY(CT) do { \
                f32x16 oacc, X0, X1; \
                _Pragma("unroll") for (int i = 0; i < 16; ++i) { oacc[i] = 0.f; X0[i] = 0.f; X1[i] = 0.f; } \
                bf16x8 qa[8], sbv[8], ka0[8], ka1[8]; \
                _Pragma("unroll") for (int ks = 0; ks < 8; ++ks) { qa[ks] = *(const LAS bf16x8*)(Qg + ((CT) * 32 + r) * 272 + ks * 32 + hf * 16); \
                    sbv[ks] = *(const LAS bf16x8*)(STl + (et * 32 + r) * 272 + ks * 32 + hf * 16); \
                    ka0[ks] = *(const LAS bf16x8*)(Kg + r * 272 + ks * 32 + hf * 16); \
                    ka1[ks] = ((CT) == 1) ? *(const LAS bf16x8*)(Kg + (32 + r) * 272 + ks * 32 + hf * 16) : ka0[ks]; } \
                _Pragma("unroll") for (int ks = 0; ks < 8; ++ks) { \
                    oacc = __builtin_amdgcn_mfma_f32_32x32x16_bf16(qa[ks], sbv[ks], oacc, 0, 0, 0); \
                    X0 = __builtin_amdgcn_mfma_f32_32x32x16_bf16(ka0[ks], qa[ks], X0, 0, 0, 0); \
                    if ((CT) == 1) X1 = __builtin_amdgcn_mfma_f32_32x32x16_bf16(ka1[ks], qa[ks], X1, 0, 0, 0); } \
                _Pragma("unroll") for (int i = 0; i < 16; ++i) { const bool keep = crow(i, hf) <= r; if ((CT) == 0) X0[i] = keep ? X0[i] : 0.f; else X1[i] = keep ? X1[i] : 0.f; } \
                _Pragma("unroll") for (int s2 = 0; s2 < 2; ++s2) { \
                    { u32x4 pw; pw.x = cvtpk(X0[8 * s2 + 0], X0[8 * s2 + 1]); pw.y = cvtpk(X0[8 * s2 + 2], X0[8 * s2 + 3]); pw.z = cvtpk(X0[8 * s2 + 4], X0[8 * s2 + 5]); pw.w = cvtpk(X0[8 * s2 + 6], X0[8 * s2 + 7]); \
                      const LAS unsigned char* vp = VTl + (et * 32 + r) * 144 + (16 * s2 + 4 * hf) * 2; \
                      const u32x2 lo2 = *(const LAS u32x2*)vp, hi2 = *(const LAS u32x2*)(vp + 16); \
                      oacc = __builtin_amdgcn_mfma_f32_32x32x16_bf16(__builtin_bit_cast(bf16x8, pw), __builtin_bit_cast(bf16x8, (u32x4){lo2.x, lo2.y, hi2.x, hi2.y}), oacc, 0, 0, 0); } \
                    if ((CT) == 1) { u32x4 pw; pw.x = cvtpk(X1[8 * s2 + 0], X1[8 * s2 + 1]); pw.y = cvtpk(X1[8 * s2 + 2], X1[8 * s2 + 3]); pw.z = cvtpk(X1[8 * s2 + 4], X1[8 * s2 + 5]); pw.w = cvtpk(X1[8 * s2 + 6], X1[8 * s2 + 7]); \
                      const LAS unsigned char* vp = VTl + (et * 32 + r) * 144 + (32 + 16 * s2 + 4 * hf) * 2; \
                      const u32x2 lo2 = *(const LAS u32x2*)vp, hi2 = *(const LAS u32x2*)(vp + 16); \
                      oacc = __builtin_amdgcn_mfma_f32_32x32x16_bf16(__builtin_bit_cast(bf16x8, pw), __builtin_bit_cast(bf16x8, (u32x4){lo2.x, lo2.y, hi2.x, hi2.y}), oacc, 0, 0, 0); } } \
                bf16_t* op = yb + (tok0 + (size_t)n * 64 + (CT) * 32 + 4 * hf) * 1024 + h * 256 + es * 64 + et * 32 + r; \
                _Pragma("unroll") for (int i = 0; i < 16; ++i) op[(size_t)((i & 3) + 8 * (i >> 2)) * 1024] = (bf16_t)f2bf(oacc[i]); } while (0)
#define GLA_CHUNK(qr, kr, vr, dr) do { \
            GLA_STAGE(qr, kr, vr, dr); \
            LDS_BARRIER(); \
            if (wave < 4) { const int et = wave & 1; if ((wave >> 1) == 0) GLA_OBODY(0); else GLA_OBODY(1); } \
            if (n + 2 < n0 + GLA_CPS) GLA_LOAD(n + 2, qr, kr, vr, dr); \
            { bf16x8 ka[4], vb[4]; \
              _Pragma("unroll") for (int ks = 0; ks < 4; ++ks) { ka[ks] = *(const LAS bf16x8*)(KgT + (sdt * 32 + r) * 144 + ks * 32 + hf * 16); vb[ks] = *(const LAS bf16x8*)(VTl + (set_ * 32 + r) * 144 + ks * 32 + hf * 16); } \
              _Pragma("unroll") for (int ks = 0; ks < 4; ++ks) sacc = __builtin_amdgcn_mfma_f32_32x32x16_bf16(ka[ks], vb[ks], sacc, 0, 0, 0); } \
            _Pragma("unroll") for (int i = 0; i < 16; ++i) sacc[i] *= decl[sdt * 32 + crow(i, hf)]; \
            LDS_BARRIER(); \
            _Pragma("unroll") for (int i4 = 0; i4 < 4; ++i4) \
                *(LAS u32x2*)(STl + (set_ * 32 + r) * 272 + (sdt * 32 + 8 * i4 + 4 * hf) * 2) = (u32x2){cvtpk(sacc[4 * i4], sacc[4 * i4 + 1]), cvtpk(sacc[4 * i4 + 2], sacc[4 * i4 + 3])}; } while (0)
#pragma unroll 1
        for (int n = n0; n < n0 + GLA_CPS; ++n) {
            GLA_CHUNK(qrA, krA, vrA, drA);
            ++n;
            GLA_CHUNK(qrB, krB, vrB, drB);
        }
#undef GLA_CHUNK
#undef GLA_OBODY
        if (seg + 1 < GLA_NSPLIT) { float* sl = (float*)(ws + WS_SLOC) + ((size_t)(b * 4 + h) * 256 + es * 64 + set_ * 32 + r) * 128 + sdt * 32 + 4 * hf;
#pragma unroll
            for (int i4 = 0; i4 < 4; ++i4) *(f32x4*)(sl + 8 * i4) = (f32x4){sacc[4 * i4], sacc[4 * i4 + 1], sacc[4 * i4 + 2], sacc[4 * i4 + 3]}; }
#undef GLA_LOAD
#undef GLA_STAGE
        __syncthreads();
    }
    for (int rm_ = 0; rm_ < REPN(7); ++rm_) {   PHASE_IDS
        LAS unsigned char* Kl = lds;
        LAS unsigned char* Vl = lds + 36864;
        LAS float* tabL = (LAS float*)(lds + 71680);
        LAS int* upre = (LAS int*)(lds + 92160);
        LAS int* cntL = (LAS int*)(lds + 92160 + 4128);
        LAS int* qinfo = (LAS int*)(lds + 102400) + wave * 32;
        LAS int* sch = (LAS int*)(lds + LDS_MISC);
        __syncthreads();
        for (int i = tid; i < 8 * 640; i += NTHR) { const int hh = i / 640, d = i % 640 - 255; tabL[i] = d < 0 ? -INFINITY : (d < 128 ? tab[hh * 128 + d] : tab[1024 + hh]); }
        if (wave == 0) {
            int loc[16]; int sum = 0;
#pragma unroll
            for (int q = 0; q < 16; ++q) { const int c = (int)__hip_atomic_load(&ctl[CW_LCNT + lane * 16 + q], __ATOMIC_RELAXED, __HIP_MEMORY_SCOPE_AGENT); cntL[lane * 16 + q] = c; loc[q] = sum; sum += (256 + c + MB_CH - 1) / MB_CH; }
            int incl = sum;
            for (int off = 1; off < 64; off <<= 1) { const int o = __shfl_up(incl, off); if (lane >= off) incl += o; }
            const int excl = incl - sum;
#pragma unroll
            for (int q = 0; q < 16; ++q) upre[lane * 16 + q] = excl + loc[q];
            if (lane == 63) upre[1024] = incl;
        }
        __syncthreads();
        const int nunits = upre[1024];
        const int r = lane & 31, hf = lane >> 5;
        __syncthreads();
        if (tid == 0) sch[0] = (int)atomicAdd(&ctl[CW_QCTR + 64 * rep_ + 128 * rm_], 1u);
        __syncthreads();
        for (;;) {
            const int un = sch[0];
            if (un >= nunits) break;
            __syncthreads();
            unsigned nx_pop = 0u;
            if (tid == 0) nx_pop = atomicAdd(&ctl[CW_QCTR + 64 * rep_ + 128 * rm_], 1u);
            int lo_ = 0, hi_ = 1024;
            while (hi_ - lo_ > 1) { const int mid = (lo_ + hi_) >> 1; if (upre[mid] <= un) lo_ = mid; else hi_ = mid; }
            const int li = lo_, ch = un - upre[li], bh = li >> 5, n = li & 31, b = bh >> 3, h = bh & 7;
            const int total = 256 + cntL[li];
            const int e0 = ch * MB_CH, nent = (total - e0) < MB_CH ? (total - e0) : MB_CH, ngr = (nent + 31) >> 5;
            u32x4 kreg[4], vreg[4];
#pragma unroll
            for (int q = 0; q < 4; ++q) { const int idx = tid + q * NTHR; const int key = idx >> 3, c = idx & 7, dim = idx >> 5, kc = idx & 31;
                kreg[q] = *(const u32x4*)(Km + (size_t)(b * SEQ + n * 256 + key) * 512 + h * 64 + c * 8);
                vreg[q] = *(const u32x4*)(VT + ((size_t)bh * 64 + dim) * 8192 + n * 256 + kc * 8); }
            const unsigned short* lp = LST + (size_t)bh * LST_STRIDE + 256 * (31 * n - (n * (n - 1)) / 2);
            int tg[4], pg[4]; bool vg[4];
#pragma unroll
            for (int g2 = 0; g2 < 4; ++g2) { const int eidx = e0 + (wave + 8 * g2) * 32 + r; vg[g2] = (wave + 8 * g2 < ngr) && eidx < total; tg[g2] = n * 256; pg[g2] = 3;
                if (vg[g2]) { if (eidx < 256) tg[g2] = n * 256 + eidx; else { const unsigned ent = lp[eidx - 256]; tg[g2] = (int)(ent >> 2); pg[g2] = (int)(ent & 3u); } } }
            bf16x8 bq[4], bqn[4];
            { const bf16_t* qp = Qm + (size_t)(b * SEQ + tg[0]) * 512 + h * 64 + 8 * hf;
#pragma unroll
              for (int s4 = 0; s4 < 4; ++s4) { bq[s4] = *(const bf16x8*)(qp + 16 * s4); bqn[s4] = bq[s4]; } }
#pragma unroll
            for (int q = 0; q < 4; ++q) { const int idx = tid + q * NTHR; const int key = idx >> 3, c = idx & 7, dim = idx >> 5, kc = idx & 31;
                *(LAS u32x4*)(Kl + key * 144 + (c << 4)) = kreg[q];
                *(LAS u32x2*)(Vl + dim * 520 + (kc << 4)) = (u32x2){vreg[q].x, vreg[q].y};
                *(LAS u32x2*)(Vl + dim * 520 + (kc << 4) + 8) = (u32x2){vreg[q].z, vreg[q].w}; }
            __syncthreads();
            const float t31 = tab[1024 + h];
            const LAS unsigned char* kbase = Kl + r * 144 + hf * 16; const LAS unsigned char* vbase = Vl + r * 520 + hf * 8;
#pragma unroll 1
            for (int g2 = 0; g2 < 4; ++g2) {
                if (wave + 8 * g2 >= ngr) break;
                const bool valid = g2 == 0 ? vg[0] : (g2 == 1 ? vg[1] : (g2 == 2 ? vg[2] : vg[3])); const int t = g2 == 0 ? tg[0] : (g2 == 1 ? tg[1] : (g2 == 2 ? tg[2] : tg[3])), part = g2 == 0 ? pg[0] : (g2 == 1 ? pg[1] : (g2 == 2 ? pg[2] : pg[3]));
                if (hf == 0) qinfo[r] = valid ? ((t << 2) | part) : -1;
                if (g2 < 3 && wave + 8 * (g2 + 1) < ngr) { const int tn = g2 == 0 ? tg[1] : (g2 == 1 ? tg[2] : tg[3]); const bf16_t* qp = Qm + (size_t)(b * SEQ + tn) * 512 + h * 64 + 8 * hf;
#pragma unroll
                    for (int s4 = 0; s4 < 4; ++s4) bqn[s4] = *(const bf16x8*)(qp + 16 * s4); }
                f32x16 st[8];
                {
                    bf16x8 ka[4], kn[4];
#pragma unroll
                    for (int s4 = 0; s4 < 4; ++s4) { ka[s4] = *(const LAS bf16x8*)(kbase + s4 * 32); kn[s4] = ka[s4]; }
#pragma unroll
                    for (int kt = 0; kt < 8; ++kt) {
#pragma unroll
                        for (int i = 0; i < 16; ++i) st[kt][i] = 0.f;
                        if (kt < 7) {
#pragma unroll
                            for (int s4 = 0; s4 < 4; ++s4) kn[s4] = *(const LAS bf16x8*)(kbase + (kt + 1) * 4608 + s4 * 32); }
#pragma unroll
                        for (int s4 = 0; s4 < 4; ++s4) st[kt] = __builtin_amdgcn_mfma_f32_32x32x16_bf16(ka[s4], bq[s4], st[kt], 0, 0, 0);
                        __builtin_amdgcn_sched_barrier(0);
#pragma unroll
                        for (int s4 = 0; s4 < 4; ++s4) ka[s4] = kn[s4];
                    }
                }
#pragma unroll
                for (int s4 = 0; s4 < 4; ++s4) bq[s4] = bqn[s4];
                const int rel = t - n * 256;
                const bool near = __any(valid && rel < 383);
                float cadd = t31;
                if (near) { cadd = 0.f;
                    const LAS float* tb = tabL + h * 640 + (rel < 383 ? rel : 383) - 4 * hf;
#pragma unroll
                    for (int kt = 0; kt < 8; ++kt)
#pragma unroll
                        for (int i = 0; i < 16; ++i) st[kt][i] += tb[255 - kt * 32 - (i & 3) - 8 * (i >> 2)]; }
                float mx = -INFINITY;
#pragma unroll
                for (int kt = 0; kt < 8; ++kt)
#pragma unroll
                    for (int i = 0; i < 16; ++i) mx = fmaxf(mx, st[kt][i]);
                mx = fmaxf(mx, __shfl_xor(mx, 32));
                float l = 0.f;
#pragma unroll
                for (int kt = 0; kt < 8; ++kt)
#pragma unroll
                    for (int i = 0; i < 16; ++i) { const float p = __expf(st[kt][i] - mx); st[kt][i] = p; l += p; }
                l += __shfl_xor(l, 32);
                f32x16 o0, o1;
#pragma unroll
                for (int i = 0; i < 16; ++i) { o0[i] = 0.f; o1[i] = 0.f; }
#pragma unroll
                for (int kt = 0; kt < 8; ++kt)
#pragma unroll
                    for (int s2 = 0; s2 < 2; ++s2) {
                        u32x4 pw; pw.x = cvtpk(st[kt][8 * s2 + 0], st[kt][8 * s2 + 1]); pw.y = cvtpk(st[kt][8 * s2 + 2], st[kt][8 * s2 + 3]);
                        pw.z = cvtpk(st[kt][8 * s2 + 4], st[kt][8 * s2 + 5]); pw.w = cvtpk(st[kt][8 * s2 + 6], st[kt][8 * s2 + 7]);
                        const bf16x8 pa = __builtin_bit_cast(bf16x8, pw);
#pragma unroll
                        for (int dt = 0; dt < 2; ++dt) {
                            const u32x2 lo2 = *(const LAS u32x2*)(vbase + dt * 16640 + kt * 64 + s2 * 32), hi2 = *(const LAS u32x2*)(vbase + dt * 16640 + kt * 64 + s2 * 32 + 16);
                            const bf16x8 vb = __builtin_bit_cast(bf16x8, (u32x4){lo2.x, lo2.y, hi2.x, hi2.y});
                            if (dt == 0) o0 = __builtin_amdgcn_mfma_f32_32x32x16_bf16(pa, vb, o0, 0, 0, 0); else o1 = __builtin_amdgcn_mfma_f32_32x32x16_bf16(pa, vb, o1, 0, 0, 0); }
                    }
                {
                    LAS unsigned char* ost = lds + 104448 + wave * 4608;
#pragma unroll
                    for (int i = 0; i < 16; ++i) { const int qrow = crow(i, hf);
                        *(LAS unsigned short*)(ost + qrow * 144 + r * 2) = (unsigned short)f2bf(o0[i]); *(LAS unsigned short*)(ost + qrow * 144 + 64 + r * 2) = (unsigned short)f2bf(o1[i]); }
                    asm volatile("s_waitcnt lgkmcnt(0)" ::: "memory");
                    if (valid) { const LAS u32x4* src = (const LAS u32x4*)(ost + r * 144 + hf * 64);
                        u32x4* dst = (u32x4*)(PO + (((size_t)bh * SEQ + t) * 4 + part) * 64 + hf * 32);
                        const u32x4 v0 = src[0], v1 = src[1], v2 = src[2], v3 = src[3]; dst[0] = v0; dst[1] = v1; dst[2] = v2; dst[3] = v3; }
                }
                if (hf == 0 && valid) { float* mp = ML + (((size_t)bh * SEQ + t) * 4 + part) * 2; mp[0] = mx + cadd; mp[1] = l; }
                asm volatile("s_waitcnt lgkmcnt(0)" ::: "memory");
            }
            if (tid == 0) sch[0] = (int)nx_pop;
            __syncthreads();
        }
    }
    GRID_BAR();
    }

    { PHASE_IDS
    INP(gla_norm, 9);
#pragma unroll 2
    for (int it0 = gw * 4; it0 < 32 * SEQ; it0 += NGW * 4) {
        const int it = it0 + (lane >> 4), dl = lane & 15;
        const int bh = it >> 13, t = it & (SEQ - 1), b = bh >> 3, h = bh & 7, j = t >> 8, nsel = j < 3 ? j : 3;
        const f32x4 m01 = *(const f32x4*)(ML + (size_t)it * 8), m23 = *(const f32x4*)(ML + (size_t)it * 8 + 4);
        const bf16_t* pr = PO + (size_t)it * 256 + dl * 4;
        const u32x2 p0 = *(const u32x2*)pr, p1 = *(const u32x2*)(pr + 64), p2 = *(const u32x2*)(pr + 128), p3 = *(const u32x2*)(pr + 192);
        float M = m23[2];
        if (nsel > 0) M = fmaxf(M, m01[0]); if (nsel > 1) M = fmaxf(M, m01[2]); if (nsel > 2) M = fmaxf(M, m23[0]);
        const float w3 = __expf(m23[2] - M), w0 = nsel > 0 ? __expf(m01[0] - M) : 0.f, w1 = nsel > 1 ? __expf(m01[2] - M) : 0.f, w2 = nsel > 2 ? __expf(m23[0] - M) : 0.f;
        float den = w3 * m23[3]; f32x4 o = (f32x4){bflo(p3.x), bfhi(p3.x), bflo(p3.y), bfhi(p3.y)} * w3;
        if (nsel > 0) { den += w0 * m01[1]; o += (f32x4){bflo(p0.x), bfhi(p0.x), bflo(p0.y), bfhi(p0.y)} * w0; }
        if (nsel > 1) { den += w1 * m01[3]; o += (f32x4){bflo(p1.x), bfhi(p1.x), bflo(p1.y), bfhi(p1.y)} * w1; }
        if (nsel > 2) { den += w2 * m23[1]; o += (f32x4){bflo(p2.x), bfhi(p2.x), bflo(p2.y), bfhi(p2.y)} * w2; }
        const float inv = 1.f / den;
        *(u32x2*)(ya + (size_t)(b * SEQ + t) * 512 + h * 64 + dl * 4) = (u32x2){pk2(o[0] * inv, o[1] * inv), pk2(o[2] * inv, o[3] * inv)};
    }
    for (int m = gw; m < TT; m += NGW) {
        if ((m & (SEQ - 1)) >= GLA_CPS * 64) continue;
        u32x4* yp = (u32x4*)(yb + (size_t)m * 1024 + lane * 16); const u32x4* rp = (const u32x4*)(Rb + (size_t)m * 1024 + lane * 16);
        const u32x4 a0 = yp[0], a1 = yp[1], r0 = rp[0], r1 = rp[1];
        float v[16] = {bflo(a0.x), bfhi(a0.x), bflo(a0.y), bfhi(a0.y), bflo(a0.z), bfhi(a0.z), bflo(a0.w), bfhi(a0.w), bflo(a1.x), bfhi(a1.x), bflo(a1.y), bfhi(a1.y), bflo(a1.z), bfhi(a1.z), bflo(a1.w), bfhi(a1.w)};
        const float g[16] = {bflo(r0.x), bfhi(r0.x), bflo(r0.y), bfhi(r0.y), bflo(r0.z), bfhi(r0.z), bflo(r0.w), bfhi(r0.w), bflo(r1.x), bfhi(r1.x), bflo(r1.y), bfhi(r1.y), bflo(r1.z), bfhi(r1.z), bflo(r1.w), bfhi(r1.w)};
        float ss = 0.f;
#pragma unroll
        for (int i = 0; i < 16; ++i) ss += v[i] * v[i];
        ss += __shfl_xor(ss, 1); ss += __shfl_xor(ss, 2); ss += __shfl_xor(ss, 4); ss += __shfl_xor(ss, 8);
        const float rs = rsqrtf(ss * (1.f / 256.f) + 1e-6f); const float* gn = gla_norm + (lane & 15) * 16;
#pragma unroll
        for (int i = 0; i < 16; ++i) v[i] = v[i] * rs * gn[i] * g[i];
        yp[0] = (u32x4){pk2(v[0], v[1]), pk2(v[2], v[3]), pk2(v[4], v[5]), pk2(v[6], v[7])}; yp[1] = (u32x4){pk2(v[8], v[9]), pk2(v[10], v[11]), pk2(v[12], v[13]), pk2(v[14], v[15])};
    }
    {
        constexpr int NCH1 = 128 - GLA_CPS, CG = 4, NCG = NCH1 / CG;
        LAS float* Ot = (LAS float*)lds;
        const int r = lane & 31, hf = lane >> 5;
        const float* slT = (const float*)(ws + WS_SLOC);
        for (int it = vcu; it < 16 * NCG; it += G) {
            const int bh = it / NCG, cg = it % NCG, b = bh >> 2, h = bh & 3;
            const int ct = wave & 1, et0 = (wave >> 1) * 2;
            bf16x8 sb[2][8];
#pragma unroll
            for (int tt = 0; tt < 2; ++tt) { const float* sp = slT + ((size_t)bh * 256 + (et0 + tt) * 32 + r) * 128 + 8 * hf;
#pragma unroll
                for (int ks = 0; ks < 8; ++ks) { const f32x4 x0 = *(const f32x4*)(sp + 16 * ks), x1 = *(const f32x4*)(sp + 16 * ks + 4);
                    sb[tt][ks] = __builtin_bit_cast(bf16x8, (u32x4){cvtpk(x0[0], x0[1]), cvtpk(x0[2], x0[3]), cvtpk(x1[0], x1[1]), cvtpk(x1[2], x1[3])}); } }
            const f32x4 gn4 = *(const f32x4*)(gla_norm + lane * 4);
#pragma unroll 1
            for (int c = 0; c < CG; ++c) {
                const int n = GLA_CPS + cg * CG + c;
                const size_t t0 = (size_t)b * SEQ + (size_t)n * 64;
                u32x4 qraw[8]; f32x4 pn0[8], pn1[8]; u32x2 rr[8], yl[8];
                { const bf16_t* qp = QBb + (t0 + ct * 32 + r) * 512 + h * 128 + 8 * hf; const float* pp = (const float*)(ws + WS_PN) + ((size_t)bh * 64 + (n - GLA_CPS)) * 128 + 8 * hf;
#pragma unroll
                  for (int ks = 0; ks < 8; ++ks) { qraw[ks] = *(const u32x4*)(qp + 16 * ks); pn0[ks] = *(const f32x4*)(pp + 16 * ks); pn1[ks] = *(const f32x4*)(pp + 16 * ks + 4); } }
#pragma unroll
                for (int q = 0; q < 8; ++q) { rr[q] = *(const u32x2*)(Rb + (t0 + wave * 8 + q) * 1024 + h * 256 + lane * 4); yl[q] = *(const u32x2*)(yb + (t0 + wave * 8 + q) * 1024 + h * 256 + lane * 4); }
                bf16x8 qa[8];
#pragma unroll
                for (int ks = 0; ks < 8; ++ks) { const u32x4 w = qraw[ks];
                    qa[ks] = __builtin_bit_cast(bf16x8, (u32x4){cvtpk(bflo(w.x) * pn0[ks][0], bfhi(w.x) * pn0[ks][1]), cvtpk(bflo(w.y) * pn0[ks][2], bfhi(w.y) * pn0[ks][3]),
                                                               cvtpk(bflo(w.z) * pn1[ks][0], bfhi(w.z) * pn1[ks][1]), cvtpk(bflo(w.w) * pn1[ks][2], bfhi(w.w) * pn1[ks][3])}); }
                __syncthreads();
#pragma unroll
                for (int tt = 0; tt < 2; ++tt) {
                    f32x16 a0;
#pragma unroll
                    for (int i = 0; i < 16; ++i) a0[i] = 0.f;
#pragma unroll
                    for (int ks = 0; ks < 8; ++ks) a0 = __builtin_amdgcn_mfma_f32_32x32x16_bf16(qa[ks], sb[tt][ks], a0, 0, 0, 0);
#pragma unroll
                    for (int i = 0; i < 16; ++i) Ot[(ct * 32 + crow(i, hf)) * 260 + (et0 + tt) * 32 + r] = a0[i];
                }
                __syncthreads();
#pragma unroll
                for (int q = 0; q < 8; ++q) { const int cr = wave * 8 + q; f32x4 o4 = *(const LAS f32x4*)(Ot + cr * 260 + lane * 4);
                    o4 += (f32x4){bflo(yl[q].x), bfhi(yl[q].x), bflo(yl[q].y), bfhi(yl[q].y)};
                    const float rs = rsqrtf(wave_sum((o4[0] * o4[0] + o4[1] * o4[1]) + (o4[2] * o4[2] + o4[3] * o4[3])) * (1.f / 256.f) + 1e-6f);
                    *(u32x2*)(yb + (t0 + cr) * 1024 + h * 256 + lane * 4) = (u32x2){pk2(o4[0] * rs * gn4[0] * bflo(rr[q].x), o4[1] * rs * gn4[1] * bfhi(rr[q].x)), pk2(o4[2] * rs * gn4[2] * bflo(rr[q].y), o4[3] * rs * gn4[3] * bfhi(rr[q].y))}; }
            }
            __syncthreads();
        }
    }
    }
    GRID_BAR();

    {
        const int rot = (bx & 7) % 3;
#pragma unroll 1
        for (int step = 0; step < 3; ++step) {
            if (step == rot) {
                PHASE_IDS
                INP(w_gate, 16); INP(w_up, 18);
                convert_items(32 * 16 * 64, gw, NGW, scr, lane, [=](int it) -> CvItem {
                    const int e = it >> 10, q = it & 1023, kb = q >> 6, nb = q & 63;
                    const int dr0 = nb * 32, pn = dr0 >> 8, bj = (dr0 >> 7) & 1, cc = dr0 & 127;
                    const float* src = (bj ? w_up : w_gate) + (size_t)e * 1024 * 1024;
                    return CvItem{src + (size_t)(kb * 64) * 1024 + pn * 128 + cc, (bf16_t*)((unsigned char*)WguT + (size_t)e * 2048 * 1024 + (size_t)dr0 * 1024 + kb * 64), 1024, 1024, 32, 32.f}; });
            } else if (step - (step > rot ? 1 : 0) == 0) {
                pg8::DenseOrder S; S.init(TT, 1024, G, bx, ya, 512, WpaT, 512); S.reps = REPN(4); EpiMix<0> E{(const unsigned char*)GT, MIX};
                pg8::gemm_phase<EpiMix<0>, pg8::DenseOrder, false, 512, 512, 8>(lds, S, E);
            } else {
                pg8::DenseOrder S; S.init(TT, 1024, G, bx, yb, 1024, WpbT, 1024); S.reps = REPN(4); EpiMix<1> E{(const unsigned char*)GT, MIX};
                pg8::gemm_phase<EpiMix<1>, pg8::DenseOrder, false, 1024, 1024, 16>(lds, S, E);
            }
            asm volatile("s_waitcnt vmcnt(0)" ::: "memory"); __syncthreads();
        }
    }
    GRID_BAR();

    {
#pragma unroll 1
        for (int step = 0; step < 2; ++step) {
            if (step == (bx & 1)) {
                INP(x, 0);
                pg8::DenseOrder S; S.init(TT, 1024, G, bx, MIX, 1024, WoutT, 1024); S.reps = REPN(4); EpiX1 E{x, mod + 2048, out};
                pg8::gemm_phase<EpiX1, pg8::DenseOrder, false, 1024, 1024, 16>(lds, S, E);
            } else {
                PHASE_IDS
                INP(w_down, 20);
                convert_items(32 * 16 * 32, gw, NGW, scr, lane, [=](int it) -> CvItem { const int e = it / 512, q = it % 512, kb = q / 32, nb = q % 32;
                    return CvItem{w_down + (size_t)e * 1024 * 1024 + (size_t)(kb * 64) * 1024 + nb * 32, (bf16_t*)((unsigned char*)WdT + (size_t)e * 1024 * 1024 + (size_t)(nb * 32) * 1024 + kb * 64), 1024, 1024, 32, 32.f}; });
            }
            asm volatile("s_waitcnt vmcnt(0)" ::: "memory"); __syncthreads();
        }
    }
    GRID_BAR();

    {
        PHASE_IDS
        INP(norm_ffn, 13); INP(w_router, 14); INP(b_router, 15);
        LAS float* wr_t = (LAS float*)lds;
        LAS int* lcnt = (LAS int*)(lds + LDS_IDX);
        LAS int* asg = (LAS int*)(lds + LDS_IDX + 256);
        LAS float* lgs = (LAS float*)(lds + LDS_IDX + 256 + 4096) + wave * 80;
        { f32x4 wv[16];
#pragma unroll
          for (int q = 0; q < 16; ++q) wv[q] = *(const f32x4*)(w_router + (size_t)(q * NTHR + tid) * 4);
#pragma unroll
          for (int q = 0; q < 16; ++q) { const int i4 = q * NTHR + tid, k = i4 >> 3, e0 = (i4 & 7) * 4;
              wr_t[(e0 + 0) * 1024 + k] = wv[q][0]; wr_t[(e0 + 1) * 1024 + k] = wv[q][1]; wr_t[(e0 + 2) * 1024 + k] = wv[q][2]; wr_t[(e0 + 3) * 1024 + k] = wv[q][3]; } }
        if (tid < 32) lcnt[tid] = 0;
        __syncthreads();
        f32x4 xnA[4], xnB[4];
        { const f32x4* xa = (const f32x4*)(out + (size_t)gw * DM) + lane; const f32x4* xb = (const f32x4*)(out + (size_t)(gw + NGW) * DM) + lane;
#pragma unroll
          for (int j = 0; j < 4; ++j) { xnA[j] = xa[64 * j]; xnB[j] = xb[64 * j]; } }
        int li = 0;
        for (int m = gw; m < TT; m += 2 * NGW, li += 2) {
            const int mB = m + NGW, b = m >> 13, bB = mB >> 13;
            f32x4 vA[4], vB[4]; float sA = 0.f, sB = 0.f;
            f32x4 nw_[4], shA_[4], scA_[4], shB_[4], scB_[4];
#pragma unroll
            for (int j = 0; j < 4; ++j) { const int c = 256 * j + 4 * lane; nw_[j] = *(const f32x4*)(norm_ffn + c);
                shA_[j] = *(const f32x4*)(mod + b * 6144 + 3072 + c); scA_[j] = *(const f32x4*)(mod + b * 6144 + 4096 + c);
                shB_[j] = *(const f32x4*)(mod + bB * 6144 + 3072 + c); scB_[j] = *(const f32x4*)(mod + bB * 6144 + 4096 + c); }
#pragma unroll
            for (int j = 0; j < 4; ++j) { vA[j] = xnA[j]; vB[j] = xnB[j];
                sA += (vA[j][0] * vA[j][0] + vA[j][1] * vA[j][1]) + (vA[j][2] * vA[j][2] + vA[j][3] * vA[j][3]); sB += (vB[j][0] * vB[j][0] + vB[j][1] * vB[j][1]) + (vB[j][2] * vB[j][2] + vB[j][3] * vB[j][3]); }
            { const int mnA = (m + 2 * NGW < TT) ? m + 2 * NGW : m, mnB = mnA + NGW; const f32x4* xa = (const f32x4*)(out + (size_t)mnA * DM) + lane; const f32x4* xb = (const f32x4*)(out + (size_t)mnB * DM) + lane;
#pragma unroll
                for (int j = 0; j < 4; ++j) { xnA[j] = xa[64 * j]; xnB[j] = xb[64 * j]; } }
            const float rsA = rsqrtf(wave_sum(sA) * (1.f / DM) + 1e-6f), rsB = rsqrtf(wave_sum(sB) * (1.f / DM) + 1e-6f);
            unsigned* oA = (unsigned*)((unsigned char*)H2 + (size_t)m * DM) + lane; unsigned* oB = (unsigned*)((unsigned char*)H2 + (size_t)mB * DM) + lane;
#pragma unroll
            for (int j = 0; j < 4; ++j) { const f32x4 w = nw_[j];
                { const f32x4 sh = shA_[j], sc = scA_[j];
                  vA[j] = (vA[j] * rsA) * w * (sc + 1.f) + sh;
                  int w8 = 0; w8 = __builtin_amdgcn_cvt_pk_fp8_f32(vA[j][0], vA[j][1], w8, false); w8 = __builtin_amdgcn_cvt_pk_fp8_f32(vA[j][2], vA[j][3], w8, true); oA[64 * j] = (unsigned)w8; }
                { const f32x4 sh = shB_[j], sc = scB_[j];
                  vB[j] = (vB[j] * rsB) * w * (sc + 1.f) + sh;
                  int w8 = 0; w8 = __builtin_amdgcn_cvt_pk_fp8_f32(vB[j][0], vB[j][1], w8, false); w8 = __builtin_amdgcn_cvt_pk_fp8_f32(vB[j][2], vB[j][3], w8, true); oB[64 * j] = (unsigned)w8; } }
            float eaA[32], eaB[32];
            f32x2_t pv[4][4];
#pragma unroll
            for (int j = 0; j < 4; ++j)
#pragma unroll
                for (int i = 0; i < 4; ++i) pv[j][i] = (f32x2_t){vA[j][i], vB[j][i]};
#pragma unroll
            for (int e = 0; e < 32; ++e) { f32x2_t a = {0.f, 0.f}, a2 = {0.f, 0.f};
#pragma unroll
                for (int j = 0; j < 4; ++j) { const f32x4 w = *(const LAS f32x4*)(wr_t + e * 1024 + 256 * j + 4 * lane);
                    a += pv[j][0] * w[0]; a2 += pv[j][1] * w[1]; a += pv[j][2] * w[2]; a2 += pv[j][3] * w[3]; }
                a += a2; eaA[e] = a[0]; eaB[e] = a[1]; if ((e & 3) == 3) __builtin_amdgcn_sched_barrier(0); }
            float r32[32], r16[16], r8[8], r4[4], r2[2];
            { const bool hi = (lane & 32) != 0;
#pragma unroll
              for (int q = 0; q < 32; ++q) { const float mine = hi ? eaB[q] : eaA[q], oth = hi ? eaA[q] : eaB[q]; r32[q] = mine + __shfl_xor(oth, 32); } }
            { const bool hi = (lane & 16) != 0;
#pragma unroll
              for (int q = 0; q < 16; ++q) { const float mine = hi ? r32[q + 16] : r32[q], oth = hi ? r32[q] : r32[q + 16]; r16[q] = mine + __shfl_xor(oth, 16); } }
            { const bool hi = (lane & 8) != 0;
#pragma unroll
              for (int q = 0; q < 8; ++q) { const float mine = hi ? r16[q + 8] : r16[q], oth = hi ? r16[q] : r16[q + 8]; r8[q] = mine + __shfl_xor(oth, 8); } }
            { const bool hi = (lane & 4) != 0;
#pragma unroll
              for (int q = 0; q < 4; ++q) { const float mine = hi ? r8[q + 4] : r8[q], oth = hi ? r8[q] : r8[q + 4]; r4[q] = mine + __shfl_xor(oth, 4); } }
            { const bool hi = (lane & 2) != 0;
#pragma unroll
              for (int q = 0; q < 2; ++q) { const float mine = hi ? r4[q + 2] : r4[q], oth = hi ? r4[q] : r4[q + 2]; r2[q] = mine + __shfl_xor(oth, 2); } }
            float g;
            { const bool hi = (lane & 1) != 0; const float mine = hi ? r2[1] : r2[0], oth = hi ? r2[0] : r2[1]; g = mine + __shfl_xor(oth, 1); }
            const int me = lane & 31, rsel = lane >> 5, mrow = rsel ? mB : m;
            g += b_router[me];
            LAS float* lg = lgs + rsel * 40;
            lg[me] = g;
            asm volatile("s_waitcnt lgkmcnt(0)" ::: "memory");
            int rank = 0;
#pragma unroll
            for (int q = 0; q < 8; ++q) { const f32x4 o4 = *(const LAS f32x4*)(lg + 4 * q);
#pragma unroll
                for (int u = 0; u < 4; ++u) { const int oe = 4 * q + u; rank += (o4[u] > g || (o4[u] == g && oe < me)) ? 1 : 0; } }
            if (rank < 4) { lg[32 + rank] = g; ((LAS int*)lg)[36 + rank] = me; }
            asm volatile("s_waitcnt lgkmcnt(0)" ::: "memory");
            if (me < 4) {
                const float t0 = lg[32], t1 = lg[33], t2 = lg[34], t3 = lg[35];
                const float e1 = __expf(t1 - t0), e2 = __expf(t2 - t0), e3 = __expf(t3 - t0); const float inv = 1.f / (1.f + e1 + e2 + e3);
                const float wk = (me == 0 ? 1.f : (me == 1 ? e1 : (me == 2 ? e2 : e3))) * inv;
                const int ek = ((LAS int*)lg)[36 + me];
                topw[mrow * 4 + me] = wk;
                const int lp = __hip_atomic_fetch_add(lcnt + ek, 1, __ATOMIC_RELAXED, __HIP_MEMORY_SCOPE_WORKGROUP);
                const int slot = ((li + rsel) * NWAVES + wave) * 4 + me;
                asg[slot * 2] = (ek << 16) | lp; asg[slot * 2 + 1] = mrow * 4 + me;
            }
            asm volatile("s_waitcnt lgkmcnt(0)" ::: "memory");
        }
        __syncthreads();
        if (tid < 32) { const int c = lcnt[tid]; lcnt[tid] = c ? (int)atomicAdd(&ctl[CW_CNT + tid], (unsigned)c) : 0; }
        __syncthreads();
        { const int nrows = (TT - gw + NGW - 1) / NGW;
          (void)nrows;
          for (int sl = tid; sl < 16 * NWAVES * 4; sl += NTHR) { const int row_i = sl >> 2; const int m_ = (vcu * NWAVES + (row_i & 7)) + (row_i >> 3) * NGW;
              if (m_ < TT) { const int pk = asg[sl * 2], a_ = asg[sl * 2 + 1]; const int e_ = pk >> 16, lp_ = pk & 0xffff; list[(size_t)e_ * TT + lcnt[e_] + lp_] = a_; } } }
    }
    GRID_BAR();

    {
        PHASE_IDS
        LAS int* blkE = (LAS int*)(lds + LDS_BLKE);
        INP(b_gate, 17); INP(b_up, 19); INP(b_down, 21); INP(norm_final, 22); LAS int* blkR = (LAS int*)(lds + LDS_BLKR); LAS int* idxT = (LAS int*)(lds + LDS_IDX); LAS int* misc = (LAS int*)(lds + LDS_MISC);
        if (tid == 0) { int nb = 0;
            for (int e = 0; e < 32; ++e) { const int c = (int)__hip_atomic_load(&ctl[CW_CNT + e], __ATOMIC_RELAXED, __HIP_MEMORY_SCOPE_AGENT); const int k = (c + 255) >> 8;
                for (int q = 0; q < k; ++q) { blkE[nb] = e; blkR[nb] = q * 256; ++nb; } }
            misc[1] = nb; }
        __syncthreads();
        const int nb = misc[1];
        const int cp = vcu;
        pg8::MoeOrder<true, 8, 1024> S1{0, nb, G, cp, (const char*)H2, (const char*)WguT, blkE, idxT};
        { pg8::Unit u;
          for (int i = 0; S1.next(i, u); ++i) {
              for (int rr = tid; rr < 256; rr += NTHR) { const int e = u.e; const int r = blkR[u.pm] + rr; const int cnt = (int)__hip_atomic_load(&ctl[CW_CNT + e], __ATOMIC_RELAXED, __HIP_MEMORY_SCOPE_AGENT);
                  const bool ok = r < cnt; const int a = list[(size_t)e * TT + (ok ? r : 0)];
                  idxT[i * 256 + rr] = a >> 2;
                  if (ok && u.pn == 0) dest[a] = u.pm * 256 + rr; }
          } }
        __syncthreads();
        { EpiAct E{b_gate, b_up, (unsigned char*)ACT};
          pg8::gemm_phase<EpiAct, pg8::MoeOrder<true, 8, 1024>, true, 512, 512, 8, true>(lds, S1, E); }
        GRID_BAR();
        { pg8::MoeOrder<false, 4, 1024> S2{0, nb, G, cp, (const char*)ACT, (const char*)WdT, blkE, idxT}; EpiDown E{b_down, (unsigned char*)YA, 0};
          pg8::gemm_phase<EpiDown, pg8::MoeOrder<false, 4, 1024>, false, 512, 512, 8, true>(lds, S2, E); }
        GRID_BAR();
        {
            int dn[4]; float wn[4]; f32x4 xn4[4];
#define P11_LOAD(m_) do { _Pragma("unroll") for (int k = 0; k < 4; ++k) { dn[k] = dest[(m_) * 4 + k]; wn[k] = topw[(m_) * 4 + k]; } \
                const f32x4* xr_ = (const f32x4*)(out + (size_t)(m_) * DM) + lane; _Pragma("unroll") for (int j = 0; j < 4; ++j) xn4[j] = xr_[64 * j]; } while (0)
            if (gw < TT) P11_LOAD(gw);
            for (int m = gw; m < TT; m += NGW) {
                const int b = m >> 13;
                unsigned yv[4][4]; float wk[4]; f32x4 xc[4];
#pragma unroll
                for (int k = 0; k < 4; ++k) { const int sl = dn[k]; wk[k] = wn[k];
                    const unsigned* y2 = (const unsigned*)((const unsigned char*)YA + (size_t)sl * 1024) + lane;
#pragma unroll
                    for (int j = 0; j < 4; ++j) yv[k][j] = y2[64 * j]; }
#pragma unroll
                for (int j = 0; j < 4; ++j) xc[j] = xn4[j];
                { const int mn = (m + NGW < TT) ? m + NGW : m; P11_LOAD(mn); }
                f32x4 v[4];
#pragma unroll
                for (int j = 0; j < 4; ++j) { v[j] = (f32x4){0.f, 0.f, 0.f, 0.f};
#pragma unroll
                    for (int k = 0; k < 4; ++k) { const unsigned p = yv[k][j]; const f32x2_t lo = __builtin_amdgcn_cvt_pk_f32_fp8((int)p, false), hi = __builtin_amdgcn_cvt_pk_f32_fp8((int)p, true);
                        v[j] += (f32x4){lo[0], lo[1], hi[0], hi[1]} * wk[k]; } }
                float s2 = 0.f;
#pragma unroll
                for (int j = 0; j < 4; ++j) { const int c = 256 * j + 4 * lane; const f32x4 g2 = *(const f32x4*)(mod + b * 6144 + 5120 + c);
                    v[j] = xc[j] + g2 * v[j]; s2 += (v[j][0] * v[j][0] + v[j][1] * v[j][1]) + (v[j][2] * v[j][2] + v[j][3] * v[j][3]); }
                const float rs = rsqrtf(wave_sum(s2) * (1.f / DM) + 1e-6f);
                f32x4* xw = (f32x4*)(out + (size_t)m * DM) + lane;
#pragma unroll
                for (int j = 0; j < 4; ++j) { const int c = 256 * j + 4 * lane; xw[64 * j] = v[j] * rs * *(const f32x4*)(norm_final + c); }
            }
#undef P11_LOAD
        }
    }
#if PROBE >= 10
    GRID_BAR();
    if (blockIdx.x == 0) {
        volatile unsigned* tsl = (volatile unsigned*)(args.ws + WS_CTL) + 15000;
        const float ta = (float)(tsl[PROBE_A1] - tsl[PROBE_A0]) * 0.01f, tr = (float)(tsl[PROBE_R1] - tsl[PROBE_R0]) * 0.01f;
        if (threadIdx.x == 0) out[0] += ta * 0.1f;
        const float dl = sqrtf(tr * 0.02f);
        out[1024 + threadIdx.x] += dl; out[1536 + threadIdx.x] += dl;
    }
#endif
}
#undef ctl
#undef modp
#undef mod
#undef tab
#undef kmean
#undef gkl
#undef topw
#undef dest
#undef list
#undef WinT
#undef WpaT
#undef WpbT
#undef WoutT
#undef WdT
#undef WguT
#undef XN
#undef Qm
#undef Km
#undef Vm
#undef QBb
#undef KBb
#undef VBb
#undef Rb
#undef GT
#undef MIX
#undef H2
#undef ACT
#undef YA
#undef YBr
#undef ya
#undef yb
#undef VT
#undef PO
#undef ML
#undef DEC
#undef LST

extern "C" void kernel_launch(void* const* d_in, const int* in_sizes, int n_in, void* d_out, int out_size, void* d_ws, size_t ws_size, hipStream_t stream) {
    static int grid = 0;
    if (grid == 0) {
        if (n_in != 23 || out_size != TT * DM || ws_size < WS_NEED) { fprintf(stderr, "kernel_launch: unexpected shapes (n_in %d out %d ws %zu)\n", n_in, out_size, ws_size); grid = -1; return; }
        int dev = 0, cus = 0, per_cu = 0;
        (void)hipGetDevice(&dev); (void)hipDeviceGetAttribute(&cus, hipDeviceAttributeMultiprocessorCount, dev);
        if (hipFuncSetAttribute((const void*)mega_fwd, hipFuncAttributeMaxDynamicSharedMemorySize, LDS_BYTES) != hipSuccess) { fprintf(stderr, "kernel_launch: hipFuncSetAttribute failed\n"); grid = -1; return; }
        if (hipOccupancyMaxActiveBlocksPerMultiprocessor(&per_cu, (const void*)mega_fwd, NTHR, LDS_BYTES) != hipSuccess || per_cu < 1) { fprintf(stderr, "kernel_launch: occupancy query failed (%d)\n", per_cu); (void)hipGetLastError(); grid = -1; return; }
        grid = cus;
    }
    if (grid < 0) return;
    (void)hipMemsetAsync((char*)d_ws + WS_CTL, 0, 65536, stream);
    Args a{};
    for (int i = 0; i < 23; ++i) a.in[i] = (const float*)d_in[i];
    a.out = (float*)d_out; a.ws = (unsigned char*)d_ws;
    void* kargs[] = {&a};
    hipError_t e = hipLaunchCooperativeKernel((const void*)mega_fwd, dim3(grid), dim3(NTHR), kargs, LDS_BYTES, stream);
    if (e != hipSuccess) fprintf(stderr, "cooperative launch failed: %s (grid %d)\n", hipGetErrorString(e), grid);
}
```

```cpp
#include <hip/hip_runtime.h>
#include <hip/hip_cooperative_groups.h>
#include <cstdio>
#include <cstdint>
#include <math.h>
namespace cg = cooperative_groups;
#ifndef PROBE
#define PROBE 0
#endif
#define REPN(k) ((PROBE == (k)) ? 2 : 1)
#ifndef PROBE_A0
#define PROBE_A0 0
#define PROBE_A1 1
#define PROBE_R0 0
#define PROBE_R1 1
#endif

#define LAS __attribute__((address_space(3)))
typedef unsigned short bf16_t;
typedef short bf16x8 __attribute__((ext_vector_type(8)));
typedef float f32x4 __attribute__((ext_vector_type(4)));
typedef unsigned u32x4 __attribute__((ext_vector_type(4)));
typedef unsigned u32x2 __attribute__((ext_vector_type(2)));
typedef float f32x16 __attribute__((ext_vector_type(16)));
typedef float f32x2_t __attribute__((ext_vector_type(2)));
typedef __bf16 bf16x2_t __attribute__((ext_vector_type(2)));
__device__ __forceinline__ unsigned cvtpk(float lo, float hi) { f32x2_t v = {lo, hi}; bf16x2_t b = __builtin_convertvector(v, bf16x2_t); return __builtin_bit_cast(unsigned, b); }
__device__ __forceinline__ int crow(int reg, int h) { return (reg & 3) + 8 * (reg >> 2) + 4 * h; }

constexpr int NB = 4, SEQ = 8192, DM = 1024, TT = NB * SEQ, DIN = 6672;
constexpr int NPROJ = 6656;
constexpr int NEXP = 32;
constexpr int P2_F8_FROM = 6;
constexpr int NWAVES = 8, NTHR = 512;
constexpr size_t MiB = (size_t)1 << 20;

constexpr size_t KiB = 1024;
constexpr size_t WS_CTL = 0;
constexpr size_t WS_MODP = 28 * MiB;
constexpr size_t WS_MOD = 896 * KiB;
constexpr size_t WS_TAB = 992 * KiB;
constexpr size_t WS_KMEAN = 1 * MiB;
constexpr size_t WS_GK = 1 * MiB + 256 * KiB;
constexpr size_t WS_TOPW = 3 * MiB + 256 * KiB;
constexpr size_t WS_DEST = 3 * MiB + 768 * KiB;
constexpr size_t WS_LIST = 4 * MiB + 256 * KiB;
constexpr size_t WS_WIN = 8 * MiB + 256 * KiB;
constexpr size_t WS_WPA = 21 * MiB + 768 * KiB;
constexpr size_t WS_WPB = 22 * MiB + 768 * KiB;
constexpr size_t WS_WOUT = 24 * MiB + 768 * KiB;
constexpr size_t WS_BIG = 28 * MiB;
constexpr size_t WS_GT = WS_BIG;
constexpr size_t WS_R = WS_BIG + 128 * MiB;
constexpr size_t WS_MIX = WS_R;
constexpr size_t WS_VB = WS_BIG + 192 * MiB;
constexpr size_t WS_QB = WS_BIG + 256 * MiB;
constexpr size_t WS_KB = WS_BIG + 288 * MiB;
constexpr size_t WS_QM = WS_BIG + 320 * MiB;
constexpr size_t WS_KM = WS_BIG + 352 * MiB;
constexpr size_t WS_VM = WS_BIG + 384 * MiB;
constexpr size_t WS_XN = WS_BIG + 416 * MiB;
constexpr size_t WS_XN8 = 508 * MiB;
constexpr size_t WS_WD = 540 * MiB;
constexpr size_t WS_X1 = 464 * MiB;
constexpr size_t WS_ACT = WS_BIG;
constexpr size_t WS_WGU = 304 * MiB;
constexpr size_t WS_H2 = 432 * MiB;
constexpr size_t WS_YA = 164 * MiB;
constexpr size_t WS_VT = WS_XN;
constexpr size_t WS_YAW = WS_XN + 32 * MiB;
constexpr size_t WS_YA8 = 92 * MiB;
constexpr size_t WS_YB8 = 108 * MiB;
constexpr size_t WS_MIX8 = 220 * MiB;
constexpr size_t WS_YBW = 508 * MiB;
constexpr size_t WS_ML = WS_VM;
constexpr size_t WS_LST = WS_VM + 8 * MiB;
constexpr size_t WS_NEED = 572 * MiB;
static_assert(WS_WOUT + 2 * MiB <= WS_BIG && WS_XN + 64 * MiB <= 508 * MiB && WS_WD + 32 * MiB <= WS_NEED, "ws map");
static_assert(WS_ACT + 136 * MiB <= WS_YA && WS_YA + 136 * MiB <= WS_WGU && WS_WGU + 128 * MiB <= WS_H2 && WS_H2 + 32 * MiB <= WS_X1 && WS_X1 + 64 * MiB <= WS_WD, "moe map");

constexpr int CW_CNT = 0;
constexpr int CW_QCTR = 64;
constexpr int CW_ERR = 128;
constexpr int CW_BAR = 4096;
constexpr int CW_LCNT = 1024;
constexpr int MB_CH = 1024;
constexpr int LST_STRIDE = 126976;
constexpr int GLA_NSPLIT = 2, GLA_CPS = (SEQ / 64) / GLA_NSPLIT;
constexpr size_t WS_SLOC = 432 * MiB;
constexpr size_t WS_PN = WS_SLOC + 9 * MiB;
static_assert(GLA_NSPLIT == 1 || GLA_NSPLIT == 2, "the correction pass below handles one later segment");

constexpr int RING_BYTES = 131072;
constexpr int LDS_IDX = RING_BYTES;
constexpr int LDS_BLKE = LDS_IDX + 17408;
constexpr int LDS_BLKR = LDS_BLKE + 2176;
constexpr int LDS_MISC = LDS_BLKR + 2176;
constexpr int LDS_PTAB = LDS_MISC + 256;
constexpr int LDS_BYTES = LDS_PTAB + 256;
static_assert(LDS_BYTES <= 163840, "LDS");

__device__ __forceinline__ unsigned f2bf(float f) { unsigned u = __builtin_bit_cast(unsigned, f); return (u + 0x7fffu + ((u >> 16) & 1u)) >> 16; }
__device__ __forceinline__ unsigned pk2(float lo, float hi) { return f2bf(lo) | (f2bf(hi) << 16); }
__device__ __forceinline__ float bf2f(unsigned short b) { return __builtin_bit_cast(float, (unsigned)b << 16); }
__device__ __forceinline__ float bflo(unsigned w) { return __builtin_bit_cast(float, w << 16); }
__device__ __forceinline__ float bfhi(unsigned w) { return __builtin_bit_cast(float, w & 0xffff0000u); }
__device__ __forceinline__ float sigm(float x) { return __builtin_amdgcn_rcpf(1.f + __builtin_amdgcn_exp2f(-1.4426950408889634f * x)); }
__device__ __forceinline__ float wave_sum(float v) {
#pragma unroll
    for (int o = 1; o < 64; o <<= 1) v += __shfl_xor(v, o);
    return v;
}

namespace pg8 {
constexpr int BM = 256, BK = 64, HALF = 128, HTB = HALF * BK * 2, NXCD = 8, WGM = 8;
__host__ __device__ __forceinline__ int lds_byte(int r, int c) { const int st = (r >> 4) * 2 + (c >> 5), rr = r & 15, cc = c & 31, ob = rr * 64 + cc * 2; return st * 1024 + (ob ^ (((ob >> 9) & 1) << 5)); }
__host__ __device__ __forceinline__ void stage_rc(int b, int& R, int& C) { const int st = b / 1024, sb = b % 1024, swz = sb ^ (((sb >> 9) & 1) << 5); R = (st >> 1) * 16 + swz / 64; C = (st & 1) * 32 + (swz % 64) / 2; }
__host__ __device__ __forceinline__ int perm32(int rho) { const int n = rho >> 4, i = rho & 15; return 8 * (i >> 2) + 4 * n + (i & 3); }

struct Unit { int pm, pn, e; const char* A; const char* B; };

struct DenseOrder {
    int nM, nN, nwg, G, c, reps; const char* A0; const char* B0; size_t astep, bstep;
    __device__ __forceinline__ void init(int M, int N, int G_, int c_, const void* A, int lda, const void* B, int ldb) { nM = M / BM; nN = N / BM; nwg = nM * nN; G = G_; c = c_; reps = 1; A0 = (const char*)A; B0 = (const char*)B; astep = (size_t)BM * lda * 2; bstep = (size_t)BM * ldb * 2; }
    __device__ __forceinline__ bool next(int i, Unit& u) const {
        const long L = (long)i * G + c; if (L >= (long)nwg * reps) return false;
        int wgid = (int)(L % nwg); { const int q = nwg / NXCD, r = nwg % NXCD, xcd = wgid % NXCD, off = wgid / NXCD; wgid = (xcd < r ? xcd * (q + 1) : r * (q + 1) + (xcd - r) * q) + off; }
        const int nig = WGM * nN, gid = wgid / nig, fm = gid * WGM, gsz = (nM - fm) < WGM ? (nM - fm) : WGM;
        u.pm = fm + ((wgid % nig) % gsz); u.pn = (wgid % nig) / gsz; u.e = 0;
        u.A = A0 + (size_t)u.pm * astep; u.B = B0 + (size_t)u.pn * bstep; return true;
    }
    __device__ __forceinline__ int gidx(int, int) const { return 0; }
};

template <bool gather, int ncol, int RB  > struct MoeOrder {
    int lo, hi, G, cp; const char* A0; const char* B0; const LAS int* blkE; const LAS int* idx;
    __device__ __forceinline__ bool next(int i, Unit& u) const {
        const long L = (long)i * G + cp; const int b = lo + (int)(L / ncol); if (b >= hi) return false;
        u.pm = b; u.pn = (int)(L % ncol); u.e = blkE[b];
        u.A = gather ? A0 : A0 + (size_t)b * (256 * RB); u.B = B0 + ((size_t)u.e * ncol + u.pn) * (size_t)(256 * RB); return true;
    }
    __device__ __forceinline__ int gidx(int ui, int row) const { return idx[ui * 256 + row]; }
};

#define PG8_WAIT_V(n) asm volatile("s_waitcnt vmcnt(" #n ")" ::: "memory")
#define PG8_WAIT_L(n) asm volatile("s_waitcnt lgkmcnt(" #n ")" ::: "memory")
#define PG8_BAR __builtin_amdgcn_s_barrier()
#define PG8_SCHED __builtin_amdgcn_sched_barrier(0)

template <class Epi, class Sched, bool GATHER, int lda, int ldb, int nt, bool FP8 = false>
__device__ __forceinline__ void gemm_phase(LAS unsigned char* lds, const Sched& S, const Epi& E) {
    int tid_ = threadIdx.x; asm volatile("" : "+v"(tid_));
    const int tid = tid_, wid = __builtin_amdgcn_readfirstlane(tid >> 6), lane = tid & 63, wr = wid >> 2, wc = wid & 3, fr = lane & 15, fq = lane >> 4;
    unsigned voffA[2], voffA1[2], voffB[2];
    { int R, C; stage_rc(tid * 16, R, C); const int Rb = Epi::PERM ? ((R & ~31) + perm32(R & 31)) : R;
      voffA[0] = (unsigned)(R * lda + C) * 2u; voffA[1] = GATHER ? voffA[0] : 0u; voffA1[0] = voffA[0]; voffA1[1] = voffA[1]; voffB[0] = (unsigned)(Rb * ldb + C) * 2u; voffB[1] = 0u; }
    constexpr size_t ASTEP2 = GATHER ? 0 : (size_t)64 * lda * 2, BSTEP2 = (size_t)64 * ldb * 2;
    const size_t kstep = (size_t)(BK * 2);
    const size_t hstepA = GATHER ? 0 : (size_t)HALF * lda * 2, hstepB = (size_t)HALF * ldb * 2;
    const unsigned ldsw = (unsigned)wid * 1024u;
    const int aoff = FP8 ? lds_byte(wr * 64 + fr, fq * 16) : lds_byte(wr * 64 + fr, fq * 8), boff = FP8 ? lds_byte(wc * 32 + fr, fq * 16) : lds_byte(wc * 32 + fr, fq * 8);
#define PG8_SA(b, h) (((b) * 2 + (h)) * HTB)
#define PG8_SB(b, h) ((4 + (b) * 2 + (h)) * HTB)
#define PG8_STAGE_A(bufoff, gbase, voff) do { _Pragma("unroll") for (int _i = 0; _i < 2; ++_i) \
        __builtin_amdgcn_global_load_lds((const unsigned*)((const char*)(gbase) + _i * ASTEP2 + (voff)[GATHER ? _i : 0]), (LAS unsigned*)(lds + (bufoff) + ldsw + _i * 8192), 16, 0, 0); } while (0)
#define PG8_STAGE_B(bufoff, gbase, voff) do { _Pragma("unroll") for (int _i = 0; _i < 2; ++_i) \
        __builtin_amdgcn_global_load_lds((const unsigned*)((const char*)(gbase) + _i * BSTEP2 + (voff)[0]), (LAS unsigned*)(lds + (bufoff) + ldsw + _i * 8192), 16, 0, 0); } while (0)
#define PG8_LDA(dst, b, h) do { if constexpr (FP8) { _Pragma("unroll") for (int m = 0; m < 4; ++m) { const v4i_ lo_ = *(const LAS v4i_*)(lds + PG8_SA(b, h) + aoff + m * 2048), hi_ = *(const LAS v4i_*)(lds + PG8_SA(b, h) + aoff + m * 2048 + 16); \
            A8[m] = (v8i_){lo_[0], lo_[1], lo_[2], lo_[3], hi_[0], hi_[1], hi_[2], hi_[3]}; } } \
        else { _Pragma("unroll") for (int m = 0; m < 4; ++m) _Pragma("unroll") for (int k = 0; k < 2; ++k) dst[m][k] = *(const LAS bf16x8*)(lds + PG8_SA(b, h) + aoff + m * 2048 + k * 1024); } } while (0)
#define PG8_LDB(dst, dst8, b, h) do { if constexpr (FP8) { _Pragma("unroll") for (int n = 0; n < 2; ++n) { const v4i_ lo_ = *(const LAS v4i_*)(lds + PG8_SB(b, h) + boff + n * 2048), hi_ = *(const LAS v4i_*)(lds + PG8_SB(b, h) + boff + n * 2048 + 16); \
            dst8[n] = (v8i_){lo_[0], lo_[1], lo_[2], lo_[3], hi_[0], hi_[1], hi_[2], hi_[3]}; } } \
        else { _Pragma("unroll") for (int n = 0; n < 2; ++n) _Pragma("unroll") for (int k = 0; k < 2; ++k) dst[n][k] = *(const LAS bf16x8*)(lds + PG8_SB(b, h) + boff + n * 2048 + k * 1024); } } while (0)
#define PG8_MMA(ai, bj, At, Bt, Bt8) do { __builtin_amdgcn_s_setprio(1); _Pragma("unroll") for (int m = 0; m < 4; ++m) _Pragma("unroll") for (int n = 0; n < 2; ++n) { \
        if constexpr (FP8) asm volatile("v_mfma_scale_f32_16x16x128_f8f6f4 %0, %1, %2, %0, %3, %3 op_sel_hi:[0,0,0]" : "+v"(acc[ai][bj][m][n]) : "v"(Bt8[n]), "v"(A8[m]), "v"(scl8));   \
        else { _Pragma("unroll") for (int k = 0; k < 2; ++k) acc[ai][bj][m][n] = __builtin_amdgcn_mfma_f32_16x16x32_bf16(Bt[n][k], At[m][k], acc[ai][bj][m][n], 0, 0, 0); } } \
        __builtin_amdgcn_s_setprio(0); } while (0)
#define PG8_GLOAD(uix) do { if constexpr (GATHER) { _Pragma("unroll") for (int _i = 0; _i < 2; ++_i) { int R_, C_; stage_rc(tid * 16 + _i * 8192, R_, C_); \
        voffA[_i] = (unsigned)(S.gidx(uix, R_) * lda + C_) * 2u; voffA1[_i] = (unsigned)(S.gidx(uix, 128 + R_) * lda + C_) * 2u; } } } while (0)
    Unit cur, nxt; int ui = 0;
    if (!S.next(0, cur)) return;
    f32x4 acc[2][2][4][2];
#pragma unroll
    for (int a = 0; a < 2; ++a)
#pragma unroll
        for (int b = 0; b < 2; ++b)
#pragma unroll
            for (int m = 0; m < 4; ++m)
#pragma unroll
                for (int n = 0; n < 2; ++n) acc[a][b][m][n] = (f32x4){0.f, 0.f, 0.f, 0.f};
    typedef int v8i_ __attribute__((ext_vector_type(8))); typedef int v4i_ __attribute__((ext_vector_type(4)));
    bf16x8 At[4][2], B0[2][2], B1[2][2]; v8i_ A8[4], B80[2], B81[2]; int scl8 = 0x7f7f7f7f; asm volatile("" : "+v"(scl8)); (void)scl8;
    const char* cA = cur.A; const char* cB = cur.B;
    PG8_GLOAD(0);
    PG8_STAGE_B(PG8_SB(0, 0), cB, voffB); PG8_STAGE_B(PG8_SB(0, 1), cB + hstepB, voffB); PG8_STAGE_A(PG8_SA(0, 0), cA, voffA); PG8_STAGE_A(PG8_SA(0, 1), cA + hstepA, voffA1);
    if (wr == 1) PG8_BAR;
    PG8_WAIT_V(2); PG8_BAR;
    PG8_STAGE_B(PG8_SB(1, 0), cB + kstep, voffB); PG8_STAGE_A(PG8_SA(1, 0), cA + kstep, voffA); PG8_STAGE_B(PG8_SB(1, 1), cB + hstepB + kstep, voffB);
    PG8_WAIT_V(6); PG8_BAR;
    for (;;) {
        const bool has_next = S.next(ui + 1, nxt);
        const char* nA = has_next ? nxt.A : cA; const char* nB = has_next ? nxt.B : cB;
#pragma unroll 1
        for (int t = 0; t < nt; t += 2) {
            const bool last = (t == nt - 2);
            const char* a1 = cA + (size_t)(t + 1) * kstep;
            const char* a2 = last ? nA : cA + (size_t)(t + 2) * kstep; const char* b2 = last ? nB : cB + (size_t)(t + 2) * kstep;
            const char* a3 = a2 + kstep; const char* b3 = b2 + kstep;
            PG8_LDB(B0, B80, 0, 0); PG8_LDB(B1, B81, 0, 1); PG8_SCHED; PG8_LDA(At, 0, 0); PG8_STAGE_A(PG8_SA(1, 1), a1 + hstepA, voffA1);
            if (GATHER && last && has_next) { PG8_GLOAD(ui + 1); }
            PG8_WAIT_V(8); PG8_WAIT_L(0); PG8_BAR; PG8_MMA(0, 0, At, B0, B80); PG8_MMA(0, 1, At, B1, B81); PG8_BAR; PG8_SCHED;
            PG8_LDA(At, 0, 1); PG8_STAGE_B(PG8_SB(0, 0), b2, voffB); PG8_STAGE_B(PG8_SB(0, 1), b2 + hstepB, voffB); PG8_STAGE_A(PG8_SA(0, 0), a2, voffA);
            PG8_WAIT_V(8); PG8_WAIT_L(0); PG8_BAR; PG8_MMA(1, 0, At, B0, B80); PG8_MMA(1, 1, At, B1, B81); PG8_BAR; PG8_SCHED;
            PG8_LDB(B0, B80, 1, 0); PG8_LDB(B1, B81, 1, 1); PG8_SCHED; PG8_LDA(At, 1, 0); PG8_STAGE_A(PG8_SA(0, 1), a2 + hstepA, voffA1);
            PG8_WAIT_V(8); PG8_WAIT_L(0); PG8_BAR; PG8_MMA(0, 0, At, B0, B80); PG8_MMA(0, 1, At, B1, B81); PG8_BAR; PG8_SCHED;
            PG8_LDA(At, 1, 1); PG8_STAGE_B(PG8_SB(1, 0), b3, voffB); PG8_STAGE_B(PG8_SB(1, 1), b3 + hstepB, voffB); PG8_STAGE_A(PG8_SA(1, 0), a3, voffA);
            PG8_WAIT_V(8); PG8_WAIT_L(0); PG8_BAR; PG8_MMA(1, 0, At, B0, B80); PG8_MMA(1, 1, At, B1, B81); PG8_BAR; PG8_SCHED;
        }
        if (wr == 0) PG8_BAR;
        if constexpr (FP8) asm volatile("s_nop 15\n\ts_nop 15" ::: "memory");
        E(acc, cur, wr, wc, fr, fq);
        if (!has_next) break;
#pragma unroll
        for (int a = 0; a < 2; ++a)
#pragma unroll
            for (int b = 0; b < 2; ++b)
#pragma unroll
                for (int m = 0; m < 4; ++m)
#pragma unroll
                    for (int n = 0; n < 2; ++n) acc[a][b][m][n] = (f32x4){0.f, 0.f, 0.f, 0.f};
        cur = nxt; cA = nA; cB = nB; ++ui;
        if (wr == 1) PG8_BAR;
    }
    PG8_WAIT_V(0);
    PG8_BAR;
#undef PG8_SA
#undef PG8_SB
#undef PG8_STAGE_A
#undef PG8_STAGE_B
#undef PG8_LDA
#undef PG8_LDB
#undef PG8_MMA
#undef PG8_GLOAD
}
}

typedef f32x4 Acc[2][2][4][2];
__device__ __forceinline__ u32x4 pack8(f32x4 a, f32x4 b) { u32x4 w; w.x = cvtpk(a[0], a[1]); w.y = cvtpk(a[2], a[3]); w.z = cvtpk(b[0], b[1]); w.w = cvtpk(b[2], b[3]); return w; }
__device__ __forceinline__ f32x4 sigm4(f32x4 v) {
    f32x4 r;
#pragma unroll
    for (int p = 0; p < 2; ++p) { const f32x2_t ea = (f32x2_t){v[2 * p], v[2 * p + 1]} * -1.4426950408889634f;
        const f32x2_t den = (f32x2_t){__builtin_amdgcn_exp2f(ea[0]), __builtin_amdgcn_exp2f(ea[1])} + 1.f;
        r[2 * p] = __builtin_amdgcn_rcpf(den[0]); r[2 * p + 1] = __builtin_amdgcn_rcpf(den[1]); }
    return r; }
__device__ __forceinline__ f32x4 silu4(f32x4 v) { return v * sigm4(v); }

struct EpiProj {
    static constexpr bool PERM = true;
    unsigned char* ws; int pn0; float pre; LAS float* kscr;
    __device__ __forceinline__ void operator()(const Acc& acc, const pg8::Unit& u, int wr, int wc, int fr, int fq) const {
        const int pn = u.pn + pn0; size_t boff; int ldc, ct, fn = 0; float sc = 1.f;
        if (pn < 2) { boff = WS_QM; ldc = 512; ct = pn; sc = 0.125f; }
        else if (pn < 4) { boff = WS_KM; ldc = 512; ct = pn - 2; }
        else if (pn < 6) { boff = WS_QB; ldc = 512; ct = pn - 4; sc = 0.08838834764831845f; }
        else if (pn < 8) { boff = WS_KB; ldc = 512; ct = pn - 6; }
        else if (pn < 10) { boff = WS_VM; ldc = 512; ct = pn - 8; }
        else if (pn < 14) { boff = WS_VB; ldc = 1024; ct = pn - 10; }
        else if (pn < 18) { boff = WS_R; ldc = 1024; ct = pn - 14; fn = 1; }
        else { boff = WS_GT; ldc = 2048; ct = pn - 18; fn = 2; }
        sc *= pre;
        bf16_t* base = (bf16_t*)(ws + boff);
        const int col0 = ct * 256 + wc * 32 + 8 * fq;
#pragma unroll
        for (int ai = 0; ai < 2; ++ai)
#pragma unroll
            for (int m = 0; m < 4; ++m) { bf16_t* rowp = base + (size_t)(u.pm * 256 + ai * 128 + wr * 64 + m * 16 + fr) * ldc + col0;
#pragma unroll
                for (int bj = 0; bj < 2; ++bj) { f32x4 v0 = acc[ai][bj][m][0] * sc, v1 = acc[ai][bj][m][1] * sc;
                    if (fn == 2) {
                        v0 = sigm4(v0) * 255.f + 0.5f; v1 = sigm4(v1) * 255.f + 0.5f;
                        const unsigned w0 = (unsigned)v0[0] | ((unsigned)v0[1] << 8) | ((unsigned)v0[2] << 16) | ((unsigned)v0[3] << 24), w1 = (unsigned)v1[0] | ((unsigned)v1[1] << 8) | ((unsigned)v1[2] << 16) | ((unsigned)v1[3] << 24);
                        *(u32x2*)((unsigned char*)base + (size_t)(u.pm * 256 + ai * 128 + wr * 64 + m * 16 + fr) * 2048 + col0 + bj * 128) = (u32x2){w0, w1};
                    } else {
                        if (fn == 1) { v0 = silu4(v0); v1 = silu4(v1); }
                        *(u32x4*)(rowp + bj * 128) = pack8(v0, v1); } } }
        if (pn == 2 || pn == 3) {
            f32x4 cs[2][2];
#pragma unroll
            for (int bj = 0; bj < 2; ++bj)
#pragma unroll
                for (int n = 0; n < 2; ++n) { f32x4 t = acc[0][bj][0][n];
#pragma unroll
                    for (int m = 1; m < 4; ++m) t += acc[0][bj][m][n];
#pragma unroll
                    for (int m = 0; m < 4; ++m) t += acc[1][bj][m][n];
                    cs[bj][n] = t; }
#pragma unroll
            for (int off = 1; off < 16; off <<= 1)
#pragma unroll
                for (int bj = 0; bj < 2; ++bj)
#pragma unroll
                    for (int n = 0; n < 2; ++n)
#pragma unroll
                        for (int i = 0; i < 4; ++i) cs[bj][n][i] += __shfl_xor(cs[bj][n][i], off);
            LAS float* sl = kscr + (wc * 4 + fq) * 16;
            if (wr == 1 && fr == 0) {
#pragma unroll
                for (int bj = 0; bj < 2; ++bj)
#pragma unroll
                    for (int n = 0; n < 2; ++n) *(LAS f32x4*)(sl + bj * 8 + n * 4) = cs[bj][n]; }
            asm volatile("s_waitcnt lgkmcnt(0)" ::: "memory"); __builtin_amdgcn_s_barrier(); asm volatile("" ::: "memory");
            if (wr == 0 && fr == 0) { const float kc = sc * (1.f / 256.f); const int b = u.pm >> 5, nblk = u.pm & 31;
#pragma unroll
                for (int bj = 0; bj < 2; ++bj) { const int h = ct * 4 + bj * 2 + (wc >> 1);
                    float* kd = (float*)(ws + WS_KMEAN) + ((size_t)(b * 8 + h) * 32 + nblk) * 64 + (wc & 1) * 32 + 8 * fq;
#pragma unroll
                    for (int n = 0; n < 2; ++n) *(f32x4*)(kd + 4 * n) = (cs[bj][n] + *(const LAS f32x4*)(sl + bj * 8 + n * 4)) * kc; } }
        }
    }
};

template <int MODE> struct EpiMix {
    static constexpr bool PERM = true;
    const unsigned char* gt; bf16_t* mix;
    __device__ __forceinline__ void operator()(const Acc& acc, const pg8::Unit& u, int wr, int wc, int fr, int fq) const {
        const int col0 = u.pn * 256 + wc * 32 + 8 * fq;
        const size_t row0 = (size_t)(u.pm * 256 + wr * 64 + fr);
        u32x2 g[2][4]; u32x4 p[2][4];
#define EMIX_ISSUE(q, s_) do { _Pragma("unroll") for (int mm = 0; mm < 2; ++mm) _Pragma("unroll") for (int bj = 0; bj < 2; ++bj) { \
            const size_t row = row0 + ((q) >> 1) * 128 + (2 * ((q) & 1) + mm) * 16; \
            g[s_][mm * 2 + bj] = *(const u32x2*)(gt + row * 2048 + MODE * 1024 + col0 + bj * 128); \
            if (MODE == 1) p[s_][mm * 2 + bj] = *(const u32x4*)(mix + row * 1024 + col0 + bj * 128); } } while (0)
        EMIX_ISSUE(0, 0); EMIX_ISSUE(1, 1);
#pragma unroll
        for (int q = 0; q < 4; ++q) { const int s_ = q & 1, ai = q >> 1;
#pragma unroll
            for (int mm = 0; mm < 2; ++mm)
#pragma unroll
                for (int bj = 0; bj < 2; ++bj) { const int m = 2 * (q & 1) + mm; const size_t row = row0 + ai * 128 + m * 16;
                    const u32x2 gg = g[s_][mm * 2 + bj]; const float q8 = 1.f / (255.f * 32.f);
                    f32x4 v0 = acc[ai][bj][m][0] * q8, v1 = acc[ai][bj][m][1] * q8;
                    v0 = (f32x4){v0[0] * (float)(gg.x & 0xffu), v0[1] * (float)((gg.x >> 8) & 0xffu), v0[2] * (float)((gg.x >> 16) & 0xffu), v0[3] * (float)(gg.x >> 24)};
                    v1 = (f32x4){v1[0] * (float)(gg.y & 0xffu), v1[1] * (float)((gg.y >> 8) & 0xffu), v1[2] * (float)((gg.y >> 16) & 0xffu), v1[3] * (float)(gg.y >> 24)};
                    if (MODE == 1) { const u32x4 pp = p[s_][mm * 2 + bj];
                        v0 += (f32x4){bflo(pp.x), bfhi(pp.x), bflo(pp.y), bfhi(pp.y)}; v1 += (f32x4){bflo(pp.z), bfhi(pp.z), bflo(pp.w), bfhi(pp.w)}; }
                    if (MODE == 1) { int w0 = 0, w1 = 0;
                        w0 = __builtin_amdgcn_cvt_pk_fp8_f32(v0[0], v0[1], w0, false); w0 = __builtin_amdgcn_cvt_pk_fp8_f32(v0[2], v0[3], w0, true);
                        w1 = __builtin_amdgcn_cvt_pk_fp8_f32(v1[0], v1[1], w1, false); w1 = __builtin_amdgcn_cvt_pk_fp8_f32(v1[2], v1[3], w1, true);
                        *(u32x2*)((unsigned char*)mix + ((long)WS_MIX8 - (long)WS_MIX) + row * 1024 + col0 + bj * 128) = (u32x2){(unsigned)w0, (unsigned)w1}; }
                    else *(u32x4*)(mix + row * 1024 + col0 + bj * 128) = pack8(v0, v1); }
            if (q == 0) EMIX_ISSUE(2, 0);
            if (q == 1) EMIX_ISSUE(3, 1);
        }
#undef EMIX_ISSUE
    }
};

struct EpiX1 {
    static constexpr bool PERM = false;
    const float* x; unsigned char* ws;
    __device__ __forceinline__ void operator()(const Acc& acc, const pg8::Unit& u, int wr, int wc, int fr, int fq) const {
        const float* g1 = (const float*)(ws + WS_MOD) + 2048; bf16_t* x1 = (bf16_t*)(ws + WS_X1);
        const int col0 = u.pn * 256 + wc * 32 + 4 * fq; const int b = u.pm >> 5;
        const size_t row0 = (size_t)(u.pm * 256 + wr * 64 + fr);
        f32x4 xv[2][4], gv[2];
#define EX1_ISSUE(q, s_) do { const int c_ = col0 + ((q) >> 2) * 128 + (((q) >> 1) & 1) * 16; gv[s_] = *(const f32x4*)(g1 + b * 6144 + c_) * (1.f / 32.f);   \
            _Pragma("unroll") for (int m = 0; m < 4; ++m) xv[s_][m] = *(const f32x4*)(x + (row0 + ((q) & 1) * 128 + m * 16) * 1024 + c_); } while (0)
        EX1_ISSUE(0, 0); EX1_ISSUE(1, 1);
#pragma unroll
        for (int q = 0; q < 8; ++q) { const int s_ = q & 1, bj = q >> 2, n = (q >> 1) & 1, ai = q & 1; const int c = col0 + bj * 128 + n * 16;
#pragma unroll
            for (int m = 0; m < 4; ++m) { const f32x4 v = xv[s_][m] + gv[s_] * acc[ai][bj][m][n];
                *(u32x2*)(x1 + (row0 + ai * 128 + m * 16) * 1024 + c) = (u32x2){cvtpk(v[0], v[1]), cvtpk(v[2], v[3])}; }
            if (q == 0) EX1_ISSUE(2, 0);
            if (q == 1) EX1_ISSUE(3, 1);
            if (q == 2) EX1_ISSUE(4, 0);
            if (q == 3) EX1_ISSUE(5, 1);
            if (q == 4) EX1_ISSUE(6, 0);
            if (q == 5) EX1_ISSUE(7, 1);
        }
#undef EX1_ISSUE
    }
};

__device__ __forceinline__ f32x4 swiglu4(f32x4 ag, f32x4 au, f32x4 bg4, f32x4 bu4) {
    f32x4 r;
#pragma unroll
    for (int p = 0; p < 2; ++p) {
        f32x2_t g = (f32x2_t){ag[2 * p], ag[2 * p + 1]} * (1.f / 32.f) + (f32x2_t){bg4[2 * p], bg4[2 * p + 1]};
        f32x2_t uu = (f32x2_t){au[2 * p], au[2 * p + 1]} * (1.f / 32.f) + (f32x2_t){bu4[2 * p], bu4[2 * p + 1]};
        g[0] = fminf(g[0], 7.f); g[1] = fminf(g[1], 7.f);
        uu[0] = fminf(fmaxf(uu[0], -7.f), 7.f); uu[1] = fminf(fmaxf(uu[1], -7.f), 7.f);
        const f32x2_t ea = g * (-1.702f * 1.4426950408889634f);
        f32x2_t den = (f32x2_t){__builtin_amdgcn_exp2f(ea[0]), __builtin_amdgcn_exp2f(ea[1])} + 1.f;
        const f32x2_t sg = (f32x2_t){__builtin_amdgcn_rcpf(den[0]), __builtin_amdgcn_rcpf(den[1])};
        const f32x2_t a = (g * sg) * (uu + 1.f);
        r[2 * p] = a[0]; r[2 * p + 1] = a[1]; }
    return r;
}
struct EpiAct {
    static constexpr bool PERM = true;
    const float* bg; const float* bu; unsigned char* act;
    __device__ __forceinline__ void operator()(const Acc& acc, const pg8::Unit& u, int wr, int wc, int fr, int fq) const {
        const int col0 = u.pn * 128 + wc * 32 + 8 * fq;
        const f32x4 g0 = *(const f32x4*)(bg + u.e * 1024 + col0), g1 = *(const f32x4*)(bg + u.e * 1024 + col0 + 4);
        const f32x4 u0 = *(const f32x4*)(bu + u.e * 1024 + col0), u1 = *(const f32x4*)(bu + u.e * 1024 + col0 + 4);
#pragma unroll
        for (int ai = 0; ai < 2; ++ai)
#pragma unroll
            for (int m = 0; m < 4; ++m) { const size_t row = (size_t)u.pm * 256 + ai * 128 + wr * 64 + m * 16 + fr;
                const f32x4 a0 = swiglu4(acc[ai][0][m][0], acc[ai][1][m][0], g0, u0), a1 = swiglu4(acc[ai][0][m][1], acc[ai][1][m][1], g1, u1);
                int w0 = 0, w1 = 0;
                w0 = __builtin_amdgcn_cvt_pk_fp8_f32(a0[0], a0[1], w0, false); w0 = __builtin_amdgcn_cvt_pk_fp8_f32(a0[2], a0[3], w0, true);
                w1 = __builtin_amdgcn_cvt_pk_fp8_f32(a1[0], a1[1], w1, false); w1 = __builtin_amdgcn_cvt_pk_fp8_f32(a1[2], a1[3], w1, true);
                *(u32x2*)(act + row * 1024 + col0) = (u32x2){(unsigned)w0, (unsigned)w1}; }
    }
};

struct EpiDown {
    static constexpr bool PERM = true;
    const float* bd; unsigned char* y; int blk0;
    __device__ __forceinline__ void operator()(const Acc& acc, const pg8::Unit& u, int wr, int wc, int fr, int fq) const {
        const int col0 = u.pn * 256 + wc * 32 + 8 * fq;
#pragma unroll
        for (int bj = 0; bj < 2; ++bj) { const int c = col0 + bj * 128;
            const f32x4 b0 = *(const f32x4*)(bd + u.e * 1024 + c), b1 = *(const f32x4*)(bd + u.e * 1024 + c + 4);
#pragma unroll
            for (int ai = 0; ai < 2; ++ai)
#pragma unroll
                for (int m = 0; m < 4; ++m) { const size_t row = (size_t)(u.pm - blk0) * 256 + ai * 128 + wr * 64 + m * 16 + fr;
                    const f32x4 v0 = acc[ai][bj][m][0] * (1.f / 32.f) + b0, v1 = acc[ai][bj][m][1] * (1.f / 32.f) + b1; int w0 = 0, w1 = 0;
                    w0 = __builtin_amdgcn_cvt_pk_fp8_f32(v0[0], v0[1], w0, false); w0 = __builtin_amdgcn_cvt_pk_fp8_f32(v0[2], v0[3], w0, true);
                    w1 = __builtin_amdgcn_cvt_pk_fp8_f32(v1[0], v1[1], w1, false); w1 = __builtin_amdgcn_cvt_pk_fp8_f32(v1[2], v1[3], w1, true);
                    *(u32x2*)(y + row * 1024 + c) = (u32x2){(unsigned)w0, (unsigned)w1}; } }
    }
};

__device__ __forceinline__ const float* ldptr(LAS unsigned char* lds, int k) {
    const unsigned long long v = ((const LAS unsigned long long*)(lds + LDS_PTAB))[k];
    const unsigned lo = __builtin_amdgcn_readfirstlane((unsigned)v), hi = __builtin_amdgcn_readfirstlane((unsigned)(v >> 32));
    typedef const __attribute__((address_space(1))) float* gptr_t;
    return (const float*)(gptr_t)(((unsigned long long)hi << 32) | lo); }
#define INP(name, k) const float* name = ldptr(lds, k)
__device__ __forceinline__ int fresh_tid() { int t = threadIdx.x; asm volatile("" : "+v"(t)); return t; }
#define LDS_BARRIER() do { asm volatile("s_waitcnt lgkmcnt(0)" ::: "memory"); __builtin_amdgcn_s_barrier(); asm volatile("" ::: "memory"); } while (0)
#define PHASE_IDS const int tid = fresh_tid(); const int lane = tid & 63, wave = __builtin_amdgcn_readfirstlane(tid >> 6); const int gw = vcu * NWAVES + wave; LAS float* scr = (LAS float*)(lds + wave * 16384); (void)lane; (void)gw; (void)scr;

#define XB_TMO      128
#define XB_XCNT(j)  (256  + 64 * (j))
#define XB_XSUB(j)  (1280 + 64 * (j))
#define XB_XGEN(j)  (2304 + 64 * (j))
#define XB_TOP      3328
#define XB_TOPGEN   3392
#define XCD_BAR_WORDS 3456
#define XB_SPIN_CAP (1u << 20)
__device__ __forceinline__ unsigned xb_ld(unsigned* p)              { return __hip_atomic_load(p, __ATOMIC_RELAXED, __HIP_MEMORY_SCOPE_AGENT); }
__device__ __forceinline__ unsigned xb_add(unsigned* p, unsigned v) { return __hip_atomic_fetch_add(p, v, __ATOMIC_RELAXED, __HIP_MEMORY_SCOPE_AGENT); }
__device__ __forceinline__ unsigned xb_xcc_id() { return (unsigned)__builtin_amdgcn_s_getreg((3 << 11) | 20) & 0xFu; }
#define XB_SPIN(cond, bar) do { unsigned _sp = 0; while (cond) { __builtin_amdgcn_s_sleep(1); \
    if ((++_sp & 255u) == 0u) { if (xb_ld(&(bar)[XB_TMO])) break; if (_sp > XB_SPIN_CAP) { atomicAdd(&(bar)[XB_TMO], 1u); break; } } } } while (0)
struct XcdBarrier { unsigned* bar; unsigned x; volatile LAS unsigned* st; };
__device__ __forceinline__ XcdBarrier xcd_barrier_post(unsigned* bar, volatile LAS unsigned* st) {
    XcdBarrier b; b.bar = bar; b.x = xb_xcc_id(); b.st = st;
    if (threadIdx.x == 0) (void)xb_add(&bar[XB_XCNT(b.x)], 1u);
    return b;
}
__device__ __forceinline__ void xcd_barrier_complete(unsigned* bar, unsigned x, unsigned& nloc, unsigned& nx) {
    const unsigned G = gridDim.x * gridDim.y * gridDim.z;
    unsigned sum, cnt, mine, sp = 0u;
    for (;;) {
        sum = 0u; cnt = 0u; mine = 0u;
#pragma unroll
        for (unsigned j = 0; j < 16; ++j) { const unsigned c = xb_ld(&bar[XB_XCNT(j)]); sum += c; cnt += (c > 0u) ? 1u : 0u; mine = (j == x) ? c : mine; }
        if (sum == G) break;
        __builtin_amdgcn_s_sleep(1);
        if ((++sp & 255u) == 0u) { if (xb_ld(&bar[XB_TMO])) break; if (sp > XB_SPIN_CAP) { atomicAdd(&bar[XB_TMO], 1u); break; } }
    }
    nloc = mine > 0u ? mine : 1u; nx = cnt > 0u ? cnt : 1u;
}
__device__ __forceinline__ void xcd_barrier(const XcdBarrier& b) {
    asm volatile("s_waitcnt vmcnt(0)" ::: "memory");
    __syncthreads();
    if (threadIdx.x == 0) {
        unsigned* bar = b.bar;
        unsigned bxx = __builtin_amdgcn_readfirstlane(b.x); asm volatile("" : "+s"(bxx));
        __builtin_amdgcn_s_waitcnt(0);
        unsigned nloc = b.st[0], nx = b.st[1];
        if (nloc == 0u) { xcd_barrier_complete(bar, bxx, nloc, nx); b.st[0] = nloc; b.st[1] = nx; }
        const unsigned old = xb_add(&bar[XB_XSUB(bxx)], 1u);
        const unsigned gen = old / nloc;
        if (old + 1u == (gen + 1u) * nloc) {
            __builtin_amdgcn_fence(__ATOMIC_RELEASE, "agent");
            asm volatile("s_waitcnt vmcnt(0)" ::: "memory");
            const unsigned og = xb_add(&bar[XB_TOP], 1u);
            const unsigned tg = og / nx;
            if (og + 1u == (tg + 1u) * nx) xb_add(&bar[XB_TOPGEN], 1u);
            else XB_SPIN(xb_ld(&bar[XB_TOPGEN]) == tg, bar);
            __builtin_amdgcn_fence(__ATOMIC_ACQUIRE, "agent");
            xb_add(&bar[XB_XGEN(bxx)], 1u);
            asm volatile("s_waitcnt vmcnt(0)" ::: "memory");
        } else {
            XB_SPIN(xb_ld(&bar[XB_XGEN(bxx)]) == gen, bar);
            __builtin_amdgcn_fence(__ATOMIC_ACQUIRE, "agent");
            asm volatile("s_waitcnt vmcnt(0)" ::: "memory");
        }
    }
    __syncthreads();
}
struct Args {
    const float* in[23]; float* out; unsigned char* ws;
};

struct CvItem { const float* src; bf16_t* dst; int ldw, K, ncols; float f8scale; };
__device__ __forceinline__ void cv_load(f32x4 (&v)[8], const CvItem& c, int lane) {
    const int kq = lane >> 3, cq = lane & 7;
#pragma unroll
    for (int i = 0; i < 8; ++i) v[i] = (4 * cq < c.ncols) ? *(const f32x4*)(c.src + (size_t)(8 * kq + i) * c.ldw + 4 * cq) : (f32x4){0.f, 0.f, 0.f, 0.f};
}
__device__ __forceinline__ void cv_store(const f32x4 (&cur)[8], const CvItem& ci, int lane) {
    const int kq = lane >> 3, cq = lane & 7;
    if (4 * cq < ci.ncols) {
        if (ci.f8scale != 0.f) { const float sc = ci.f8scale;
#pragma unroll
            for (int j = 0; j < 4; ++j) { int w0 = 0, w1 = 0;
                w0 = __builtin_amdgcn_cvt_pk_fp8_f32(cur[0][j] * sc, cur[1][j] * sc, w0, false); w0 = __builtin_amdgcn_cvt_pk_fp8_f32(cur[2][j] * sc, cur[3][j] * sc, w0, true);
                w1 = __builtin_amdgcn_cvt_pk_fp8_f32(cur[4][j] * sc, cur[5][j] * sc, w1, false); w1 = __builtin_amdgcn_cvt_pk_fp8_f32(cur[6][j] * sc, cur[7][j] * sc, w1, true);
                *(u32x2*)((unsigned char*)ci.dst + (size_t)(4 * cq + j) * ci.K + 8 * kq) = (u32x2){(unsigned)w0, (unsigned)w1}; } }
        else {
#pragma unroll
            for (int j = 0; j < 4; ++j) { u32x4 o; o.x = pk2(cur[0][j], cur[1][j]); o.y = pk2(cur[2][j], cur[3][j]); o.z = pk2(cur[4][j], cur[5][j]); o.w = pk2(cur[6][j], cur[7][j]);
                *(u32x4*)(ci.dst + (size_t)(4 * cq + j) * ci.K + 8 * kq) = o; } }
    }
}
template <class F> __device__ __forceinline__ void convert_items(int n_items, int gw, int NGW, LAS float* scr, int lane, F get) {
    (void)scr;
    int it = gw; if (it >= n_items) return;
    bool ok1 = it + NGW < n_items;
    CvItem c0 = get(it), c1 = get(ok1 ? it + NGW : it), n0 = c0, n1 = c1; f32x4 a0[8], a1[8], b0[8], b1[8];
    cv_load(a0, c0, lane); cv_load(a1, c1, lane);
    for (;;) {
        const int itn = it + 2 * NGW; const bool h0 = itn < n_items, h1 = itn + NGW < n_items;
        if (h0) { n0 = get(itn); n1 = get(h1 ? itn + NGW : itn); cv_load(b0, n0, lane); cv_load(b1, n1, lane); }
        cv_store(a0, c0, lane); if (ok1) cv_store(a1, c1, lane);
        if (!h0) break;
        it = itn; c0 = n0; c1 = n1; ok1 = h1;
#pragma unroll
        for (int i = 0; i < 8; ++i) { a0[i] = b0[i]; a1[i] = b1[i]; }
    }
}

__global__ void __launch_bounds__(NTHR, 2) mega_fwd(Args args) {
    extern __shared__ __attribute__((aligned(16))) unsigned char lds_raw[];
    LAS unsigned char* lds = (LAS unsigned char*)lds_raw;
    cg::grid_group grid = cg::this_grid();
    const int G = gridDim.x, bx = blockIdx.x;
    { volatile LAS unsigned* mz = (volatile LAS unsigned*)(lds + LDS_MISC); if (threadIdx.x < 64) mz[threadIdx.x] = 0u;
      if (threadIdx.x == 64) { LAS unsigned long long* pt = (LAS unsigned long long*)(lds + LDS_PTAB);
#pragma unroll
          for (int k = 0; k < 23; ++k) pt[k] = (unsigned long long)args.in[k]; } }
    __syncthreads();
    XcdBarrier xbar = xcd_barrier_post((unsigned*)(args.ws + WS_CTL) + CW_BAR, (volatile LAS unsigned*)(lds + LDS_MISC) + 8);
#if PROBE >= 10
    int tsn_ = 0;
#define TSTAMP() do { if (blockIdx.x == 0) ((volatile unsigned*)(args.ws + WS_CTL))[15000 + tsn_] = (unsigned)__builtin_amdgcn_s_memrealtime(); ++tsn_; } while (0)
#else
#define TSTAMP() do {} while (0)
#endif
    TSTAMP();
#define GRID_BAR() do { xcd_barrier(xbar); TSTAMP(); } while (0)
    const int vcu = (G % 8 == 0) ? (bx % 8) * (G / 8) + bx / 8 : bx;
    const int NGW = G * NWAVES;
    unsigned char* ws = args.ws;
    float* out = args.out;
#define ctl   ((unsigned*)(ws + WS_CTL))
#define modp  ((float*)(ws + WS_MODP))
#define mod   ((float*)(ws + WS_MOD))
#define tab   ((float*)(ws + WS_TAB))
#define kmean ((float*)(ws + WS_KMEAN))
#define gkl   ((float*)(ws + WS_GK))
#define topw  ((float*)(ws + WS_TOPW))
#define dest  ((int*)(ws + WS_DEST))
#define list  ((int*)(ws + WS_LIST))
#define WinT  ((bf16_t*)(ws + WS_WIN))
#define WpaT  ((bf16_t*)(ws + WS_WPA))
#define WpbT  ((bf16_t*)(ws + WS_WPB))
#define WoutT ((bf16_t*)(ws + WS_WOUT))
#define WdT   ((bf16_t*)(ws + WS_WD))
#define WguT  ((bf16_t*)(ws + WS_WGU))
#define XN    ((bf16_t*)(ws + WS_XN))
#define Qm    ((bf16_t*)(ws + WS_QM))
#define Km    ((bf16_t*)(ws + WS_KM))
#define Vm    ((bf16_t*)(ws + WS_VM))
#define QBb   ((bf16_t*)(ws + WS_QB))
#define KBb   ((bf16_t*)(ws + WS_KB))
#define VBb   ((bf16_t*)(ws + WS_VB))
#define Rb    ((bf16_t*)(ws + WS_R))
#define GT    ((bf16_t*)(ws + WS_GT))
#define MIX   ((bf16_t*)(ws + WS_MIX))
#define H2    ((bf16_t*)(ws + WS_H2))
#define ACT   ((bf16_t*)(ws + WS_ACT))
#define YA    ((bf16_t*)(ws + WS_YA))
#define YBr   ((bf16_t*)(ws + WS_ACT))
#define ya    ((bf16_t*)(ws + WS_YAW))
#define yb    ((bf16_t*)(ws + WS_YBW))
#define VT    ((bf16_t*)(ws + WS_VT))
#define PO8   ((unsigned char*)out)
#define ML    ((float*)(ws + WS_ML))
#define DEC   ((float*)(ws + WS_SLOC + 8 * MiB))
#define LST   ((unsigned short*)(ws + WS_LST))

    {
        PHASE_IDS
        INP(cvec, 1); INP(rel_bias, 2); INP(w_ada, 3); INP(w_in, 6); INP(w_pa, 10); INP(w_pb, 11); INP(w_out, 12);
        {
            LAS float* ssl = scr;
            const bool split_ = NGW >= 768; const int mod0 = split_ ? gw - (NGW - 24 * 16) : gw, mods = split_ ? 24 * 16 : NGW;
            for (int it = mod0; it >= 0 && it < 24 * 16; it += mods) {
                const int cgp = it % 24, kc = it / 24; const int col = cgp * 256 + lane * 4;
#pragma unroll
                for (int q = 0; q < 4; ++q) { const int idx = q * 64 + lane; const int bq = idx >> 6, kq = idx & 63; const float cv = cvec[bq * 1024 + kc * 64 + kq]; ssl[idx] = cv * sigm(cv); }
                asm volatile("s_waitcnt lgkmcnt(0)" ::: "memory");
                f32x4 a0 = {0.f, 0.f, 0.f, 0.f}, a1 = a0, a2 = a0, a3 = a0;
                const float* wp = w_ada + (size_t)(kc * 64) * 6144 + col;
#pragma unroll 1
                for (int k0 = 0; k0 < 64; k0 += 32) { f32x4 w[32];
#pragma unroll
                    for (int q = 0; q < 32; ++q) w[q] = *(const f32x4*)(wp + (size_t)(k0 + q) * 6144);
#pragma unroll
                    for (int q = 0; q < 32; ++q) { a0 += w[q] * ssl[k0 + q]; a1 += w[q] * ssl[64 + k0 + q]; a2 += w[q] * ssl[128 + k0 + q]; a3 += w[q] * ssl[192 + k0 + q]; } }
                float* mp = modp + (size_t)kc * (4 * 6144) + col;
                *(f32x4*)mp = a0; *(f32x4*)(mp + 6144) = a1; *(f32x4*)(mp + 2 * 6144) = a2; *(f32x4*)(mp + 3 * 6144) = a3;
                asm volatile("s_waitcnt lgkmcnt(0)" ::: "memory");
            }
        }
        if (gw == 0) {
            for (int i = lane; i < 8 * 128; i += 64) { const int h = i >> 7, n = i & 127; int bkt;
                if (n < 16) bkt = n; else { const int l = 16 + (int)(logf((float)n / 16.f) / logf(8.f) * 16.f); bkt = l < 31 ? l : 31; }
                tab[i] = rel_bias[bkt * 8 + h]; }
            if (lane < 8) tab[1024 + lane] = rel_bias[31 * 8 + lane];
        }
        {
            constexpr int I_IN = 16 * 208, I_PA = 8 * 32, I_PB = 16 * 32, I_OUT = 16 * 32;
            constexpr int NIT = I_IN + I_PA + I_PB + I_OUT;
            const bool csplit = NGW >= 768; const int cw = gw, CW = csplit ? NGW - 24 * 16 : NGW;
            if (cw < CW) convert_items(NIT, cw, CW, scr, lane, [=](int it) -> CvItem {
                int r = it;
                if (r < I_IN) { const int kb = r / 208, nb = r % 208; const int dr0 = nb * 32; const int sc0 = dr0 < 1024 ? dr0 : (dr0 < 2048 ? dr0 + 512 : (dr0 < 2560 ? dr0 - 1024 : (dr0 < 3584 ? dr0 : dr0 + 16)));
                    if (dr0 >= P2_F8_FROM * 256) return CvItem{w_in + (size_t)(kb * 64) * DIN + sc0, (bf16_t*)((unsigned char*)WinT + (size_t)(P2_F8_FROM * 256) * 2048 + (size_t)(dr0 - P2_F8_FROM * 256) * 1024 + kb * 64), DIN, 1024, 32, 32.f};
                    return CvItem{w_in + (size_t)(kb * 64) * DIN + sc0, WinT + (size_t)dr0 * 1024 + kb * 64, DIN, 1024, 32, 0.f}; } r -= I_IN;
                if (r < I_PA) { const int kb = r / 32, nb = r % 32; return CvItem{w_pa + (size_t)(kb * 64) * 1024 + nb * 32, (bf16_t*)((unsigned char*)WpaT + (size_t)(nb * 32) * 512 + kb * 64), 1024, 512, 32, 32.f}; } r -= I_PA;
                if (r < I_PB) { const int kb = r / 32, nb = r % 32; return CvItem{w_pb + (size_t)(kb * 64) * 1024 + nb * 32, (bf16_t*)((unsigned char*)WpbT + (size_t)(nb * 32) * 1024 + kb * 64), 1024, 1024, 32, 32.f}; } r -= I_PB;
                { const int kb = r / 32, nb = r % 32; return CvItem{w_out + (size_t)(kb * 64) * 1024 + nb * 32, (bf16_t*)((unsigned char*)WoutT + (size_t)(nb * 32) * 1024 + kb * 64), 1024, 1024, 32, 32.f}; }
            });
        }
    }
    if (args.ws == nullptr) grid.sync();
    GRID_BAR();

    {
        PHASE_IDS
        INP(x, 0); INP(b_ada, 4); INP(norm_mix, 5); INP(w_in, 6);
        LAS float* smod = (LAS float*)lds;
        constexpr int NKC = 16;
        f32x4 xn_[4], xn2_[4], nmw[4];
#pragma unroll
        for (int j = 0; j < 4; ++j) nmw[j] = *(const f32x4*)(norm_mix + 256 * j + 4 * lane);
        { const f32x4* xr = (const f32x4*)(x + (size_t)gw * DM) + lane; const int m1 = (gw + NGW < TT) ? gw + NGW : gw; const f32x4* xr1 = (const f32x4*)(x + (size_t)m1 * DM) + lane;
#pragma unroll
          for (int j = 0; j < 4; ++j) { xn_[j] = xr[64 * j]; xn2_[j] = xr1[64 * j]; } }
#pragma unroll 2
        for (int i4 = tid; i4 < 4 * 2048 / 4; i4 += NTHR) { const int b = i4 >> 9, c = (i4 & 511) * 4; f32x4 pv[NKC];
#pragma unroll
            for (int kc = 0; kc < NKC; ++kc) pv[kc] = *(const f32x4*)(modp + (size_t)kc * (4 * 6144) + b * 6144 + c);
            f32x4 a = *(const f32x4*)(b_ada + c);
#pragma unroll
            for (int kc = 0; kc < NKC; ++kc) a += pv[kc];
            *(LAS f32x4*)(smod + b * 2048 + c) = a; }
#pragma unroll 1
        for (int i4 = bx * NTHR + tid; i4 < 4 * 6144 / 4; i4 += G * NTHR) { const int c = (i4 * 4) % 6144; f32x4 pv[NKC];
#pragma unroll
            for (int kc = 0; kc < NKC; ++kc) pv[kc] = *(const f32x4*)(modp + (size_t)kc * (4 * 6144) + i4 * 4);
            f32x4 a = *(const f32x4*)(b_ada + c);
#pragma unroll
            for (int kc = 0; kc < NKC; ++kc) a += pv[kc];
            *(f32x4*)(mod + i4 * 4) = a; }
        LAS unsigned char* wgf = lds + 32768;
#pragma unroll
        for (int q = 0; q < 8; ++q) { const int idx = q * NTHR + tid, k = idx >> 2, o4 = idx & 3; const f32x4 wv = *(const f32x4*)(w_in + (size_t)k * DIN + 3584 + 4 * o4);
            const int s_ = k >> 5, kq_ = (k >> 3) & 3, ii = k & 7;
#pragma unroll
            for (int j = 0; j < 4; ++j) { const unsigned hb = f2bf(wv[j]), lb = f2bf(wv[j] - __builtin_bit_cast(float, hb << 16));
                LAS unsigned short* dp = (LAS unsigned short*)(wgf + ((size_t)(s_ * 2) * 64 + (4 * o4 + j + 16 * kq_)) * 16 + ii * 2); dp[0] = (unsigned short)hb; dp[512] = (unsigned short)lb; } }
        __syncthreads();
        auto p1row = [&](int m) __attribute__((always_inline)) {
            const int b = m >> 13;
            f32x4 v[4]; float s = 0.f;
#pragma unroll
            for (int j = 0; j < 4; ++j) { v[j] = xn_[j]; xn_[j] = xn2_[j]; s += (v[j][0] * v[j][0] + v[j][1] * v[j][1]) + (v[j][2] * v[j][2] + v[j][3] * v[j][3]); }
            { const int mn = (m + 2 * NGW < TT) ? m + 2 * NGW : m; const f32x4* xr = (const f32x4*)(x + (size_t)mn * DM) + lane;
#pragma unroll
                for (int j = 0; j < 4; ++j) xn2_[j] = xr[64 * j]; }
            const float rs = rsqrtf(wave_sum(s) * (1.f / DM) + 1e-6f);
            unsigned long long* o8 = (unsigned long long*)(XN + (size_t)m * DM) + lane; unsigned* o4 = (unsigned*)(ws + WS_XN8 + (size_t)m * DM) + lane;
#pragma unroll
            for (int j = 0; j < 4; ++j) { const int c = 256 * j + 4 * lane;
                const f32x4 w = nmw[j]; const f32x4 sh = *(const LAS f32x4*)(smod + b * 2048 + c), sc = *(const LAS f32x4*)(smod + b * 2048 + 1024 + c);
                const f32x4 h = (v[j] * rs) * w * (sc + 1.f) + sh; v[j] = h;
                o8[64 * j] = (unsigned long long)pk2(h[0], h[1]) | ((unsigned long long)pk2(h[2], h[3]) << 32);
                int w8 = 0; w8 = __builtin_amdgcn_cvt_pk_fp8_f32(h[0], h[1], w8, false); w8 = __builtin_amdgcn_cvt_pk_fp8_f32(h[2], h[3], w8, true); o4[64 * j] = (unsigned)w8; }
        };
        p1row(gw);
        for (int m = gw + NGW; m < TT; m += NGW) p1row(m);
        asm volatile("s_waitcnt vmcnt(0)" ::: "memory");
        { const int lane_ = fresh_tid() & 63, t = lane_ & 15, kq = lane_ >> 4;
          for (int j0 = 0; gw + (size_t)j0 * NGW < TT; j0 += 16) {
              const int mt = gw + (j0 + t) * NGW; const bool okr = mt < TT; const int mr = okr ? mt : gw;
              const bf16_t* xr = XN + (size_t)mr * DM + 8 * kq;
              f32x4 acc = {0.f, 0.f, 0.f, 0.f}; u32x4 ca[8], cn[8];
#pragma unroll
              for (int u = 0; u < 8; ++u) ca[u] = *(const u32x4*)(xr + 32 * u);
#pragma unroll
              for (int c = 0; c < 4; ++c) {
                  if (c < 3) {
#pragma unroll
                      for (int u = 0; u < 8; ++u) cn[u] = *(const u32x4*)(xr + 32 * (8 * c + 8 + u)); }
#pragma unroll
                  for (int u = 0; u < 8; ++u) { const int s_ = 8 * c + u; const LAS unsigned char* wp = wgf + (size_t)s_ * 2048 + lane_ * 16;
                      const bf16x8 wh = *(const LAS bf16x8*)wp, wl = *(const LAS bf16x8*)(wp + 1024), xa = __builtin_bit_cast(bf16x8, ca[u]);
                      acc = __builtin_amdgcn_mfma_f32_16x16x32_bf16(wh, xa, acc, 0, 0, 0); acc = __builtin_amdgcn_mfma_f32_16x16x32_bf16(wl, xa, acc, 0, 0, 0); }
#pragma unroll
                  for (int u = 0; u < 8; ++u) ca[u] = cn[u];
              }
              if (okr) *(f32x4*)(gkl + (size_t)mt * 16 + 4 * kq) = acc;
          } }
    }
    GRID_BAR();

    {
        { pg8::DenseOrder S; S.init(TT, P2_F8_FROM * 256, G, bx, XN, 1024, WinT, 1024); S.reps = REPN(1);
          EpiProj E{ws, 0, 1.f, (LAS float*)(lds + RING_BYTES)};
          pg8::gemm_phase<EpiProj, pg8::DenseOrder, false, 1024, 1024, 16>(lds, S, E); }
        { pg8::DenseOrder S; S.init(TT, NPROJ - P2_F8_FROM * 256, G, bx, ws + WS_XN8, 512, (unsigned char*)WinT + (size_t)(P2_F8_FROM * 256) * 2048, 512); S.reps = REPN(1);
          EpiProj E{ws, P2_F8_FROM, 1.f / 32.f, (LAS float*)(lds + RING_BYTES)};
          pg8::gemm_phase<EpiProj, pg8::DenseOrder, false, 512, 512, 8, true>(lds, S, E); }
    }
    GRID_BAR();

    {
    PHASE_IDS
    {
        LAS unsigned short* tl = (LAS unsigned short*)(lds + wave * 16384);
        for (int it = gw; it < 32 * 128; it += NGW) {
            const int bh = it >> 7, tt = it & 127, b = bh >> 3, h = bh & 7;
            const u32x4* vr = (const u32x4*)(Vm + (size_t)(b * SEQ + tt * 64 + lane) * 512 + h * 64);
#pragma unroll
            for (int c8 = 0; c8 < 8; ++c8) { const u32x4 v = vr[c8];
                tl[(c8 * 8 + 0) * 72 + lane] = (unsigned short)(v.x & 0xffff); tl[(c8 * 8 + 1) * 72 + lane] = (unsigned short)(v.x >> 16);
                tl[(c8 * 8 + 2) * 72 + lane] = (unsigned short)(v.y & 0xffff); tl[(c8 * 8 + 3) * 72 + lane] = (unsigned short)(v.y >> 16);
                tl[(c8 * 8 + 4) * 72 + lane] = (unsigned short)(v.z & 0xffff); tl[(c8 * 8 + 5) * 72 + lane] = (unsigned short)(v.z >> 16);
                tl[(c8 * 8 + 6) * 72 + lane] = (unsigned short)(v.w & 0xffff); tl[(c8 * 8 + 7) * 72 + lane] = (unsigned short)(v.w >> 16); }
            asm volatile("s_waitcnt lgkmcnt(0)" ::: "memory");
            u32x4* dst = (u32x4*)(VT + ((size_t)bh * 64 + lane) * 8192 + tt * 64);
#pragma unroll
            for (int c8 = 0; c8 < 8; ++c8) dst[c8] = *(const LAS u32x4*)(tl + lane * 72 + c8 * 8);
            asm volatile("s_waitcnt lgkmcnt(0)" ::: "memory");
        }
    }
    }

    {
        PHASE_IDS
        INP(w_gk_up, 7); INP(b_gk, 8);
        LAS float* gks = (LAS float*)(lds + wave * 16384 + 10240);
        const int d0 = 2 * lane;
        for (int it = gw; it < 16 * 128; it += NGW) {
            const int bhh = it >> 7, n = it & 127, b = bhh >> 2, h = bhh & 3;
            const size_t t0 = (size_t)b * SEQ + (size_t)n * 64;
            f32x2_t w01[16];
#pragma unroll
            for (int q = 0; q < 16; ++q) w01[q] = *(const f32x2_t*)(w_gk_up + q * 512 + h * 128 + d0);
            const f32x2_t bias01 = *(const f32x2_t*)(b_gk + h * 128 + d0);
            { const f32x4* gp = (const f32x4*)(gkl + (t0 + lane) * 16);
#pragma unroll
              for (int q = 0; q < 4; ++q) *(LAS f32x4*)(gks + lane * 16 + 4 * q) = gp[q]; }
            asm volatile("s_waitcnt lgkmcnt(0)" ::: "memory");
            f32x2_t run2 = {0.f, 0.f};
            const bf16_t* qrow = QBb + t0 * 512 + h * 128 + d0; const bf16_t* krow = KBb + t0 * 512 + h * 128 + d0;
#pragma unroll 1
            for (int c0 = 0; c0 < 64; c0 += 16) {
                unsigned qv[16], kv[16];
#pragma unroll
                for (int i = 0; i < 16; ++i) { qv[i] = *(const unsigned*)(qrow + (size_t)(c0 + i) * 512); kv[i] = *(const unsigned*)(krow + (size_t)(c0 + i) * 512); }
#pragma unroll
                for (int i = 0; i < 16; ++i) { const LAS f32x4* gp = (const LAS f32x4*)(gks + (c0 + i) * 16); f32x2_t s2 = bias01;
#pragma unroll
                    for (int q4 = 0; q4 < 4; ++q4) { const f32x4 g4 = gp[q4];
                        s2 += w01[4 * q4] * g4[0]; s2 += w01[4 * q4 + 1] * g4[1]; s2 += w01[4 * q4 + 2] * g4[2]; s2 += w01[4 * q4 + 3] * g4[3]; }
                    const float L2E = 1.4426950408889634f;
                    const float l0 = fminf(s2[0], 0.f) * L2E - __builtin_amdgcn_logf(1.f + __builtin_amdgcn_exp2f(-fabsf(s2[0]) * L2E));
                    const float l1 = fminf(s2[1], 0.f) * L2E - __builtin_amdgcn_logf(1.f + __builtin_amdgcn_exp2f(-fabsf(s2[1]) * L2E));
                    run2[0] += l0 * (1.f / 16.f); run2[1] += l1 * (1.f / 16.f);
                    *(unsigned*)(const_cast<bf16_t*>(qrow) + (size_t)(c0 + i) * 512) = cvtpk(bflo(qv[i]) * __builtin_amdgcn_exp2f(run2[0]), bfhi(qv[i]) * __builtin_amdgcn_exp2f(run2[1]));
                    *(unsigned*)(const_cast<bf16_t*>(krow) + (size_t)(c0 + i) * 512) = cvtpk(bflo(kv[i]) * __builtin_amdgcn_exp2f(-run2[0]), bfhi(kv[i]) * __builtin_amdgcn_exp2f(-run2[1])); }
            }
            { float* dc = DEC + ((size_t)bhh * 128 + n) * 128 + d0; dc[0] = __builtin_amdgcn_exp2f(run2[0]); dc[1] = __builtin_amdgcn_exp2f(run2[1]); }
            asm volatile("s_waitcnt lgkmcnt(0)" ::: "memory");
        }
    }

    {
        PHASE_IDS
        LAS unsigned* ebuf = (LAS unsigned*)(lds + 32768);
        LAS int* lcn = (LAS int*)(lds + 32768 + 12288);
        const int r = lane & 31, hf = lane >> 5;
        for (int wgi = vcu; wgi < 256; wgi += G) {
            const int bh = wgi >> 3, tq0 = (wgi & 7) * 1024, b = bh >> 3, h = bh & 7;
            __syncthreads();
            if (tid < 64) lcn[tid] = 0;
            bf16x8 ah[4], al[4];
            { const float* kp = kmean + ((size_t)bh * 32 + r) * 64 + 8 * hf;
#pragma unroll
              for (int s4 = 0; s4 < 4; ++s4) { const f32x4 k0 = *(const f32x4*)(kp + 16 * s4), k1 = *(const f32x4*)(kp + 16 * s4 + 4);
                  const float kv[8] = {k0[0], k0[1], k0[2], k0[3], k1[0], k1[1], k1[2], k1[3]}; unsigned hw[4], lw[4];
#pragma unroll
                  for (int q = 0; q < 4; ++q) { const unsigned h0 = f2bf(kv[2 * q]), h1 = f2bf(kv[2 * q + 1]);
                      hw[q] = h0 | (h1 << 16); lw[q] = pk2(kv[2 * q] - __builtin_bit_cast(float, h0 << 16), kv[2 * q + 1] - __builtin_bit_cast(float, h1 << 16)); }
                  ah[s4] = __builtin_bit_cast(bf16x8, (u32x4){hw[0], hw[1], hw[2], hw[3]}); al[s4] = __builtin_bit_cast(bf16x8, (u32x4){lw[0], lw[1], lw[2], lw[3]}); } }
            __syncthreads();
            bf16x8 bq[4], bqn[4];
            { const bf16_t* qp = Qm + (size_t)(b * SEQ + tq0 + wave * 128 + r) * 512 + h * 64 + 8 * hf;
#pragma unroll
              for (int s4 = 0; s4 < 4; ++s4) { bq[s4] = *(const bf16x8*)(qp + 16 * s4); bqn[s4] = bq[s4]; } }
#pragma unroll 1
            for (int g = 0; g < 4; ++g) {
                const int t = tq0 + wave * 128 + g * 32 + r, j = t >> 8;
                if (g < 3) { const bf16_t* qp = Qm + (size_t)(b * SEQ + t + 32) * 512 + h * 64 + 8 * hf;
#pragma unroll
                    for (int s4 = 0; s4 < 4; ++s4) bqn[s4] = *(const bf16x8*)(qp + 16 * s4); }
                if (j > 0) {
                    f32x16 gt;
#pragma unroll
                    for (int i = 0; i < 16; ++i) gt[i] = 0.f;
#pragma unroll
                    for (int s4 = 0; s4 < 4; ++s4) { gt = __builtin_amdgcn_mfma_f32_32x32x16_bf16(ah[s4], bq[s4], gt, 0, 0, 0); gt = __builtin_amdgcn_mfma_f32_32x32x16_bf16(al[s4], bq[s4], gt, 0, 0, 0); }
#pragma unroll
                    for (int i = 0; i < 16; ++i) gt[i] = (crow(i, hf) < j) ? gt[i] : -INFINITY;
                    const int nsel = j < 3 ? j : 3;
                    int sel[3];
#pragma unroll
                    for (int p = 0; p < 3; ++p) { float best = -INFINITY; int bi = 4 * hf;
#pragma unroll
                        for (int i = 0; i < 16; ++i) if (gt[i] > best) { best = gt[i]; bi = crow(i, hf); }
                        const float ob = __shfl_xor(best, 32); const int oi = __shfl_xor(bi, 32);
                        if (ob > best || (ob == best && oi < bi)) { best = ob; bi = oi; }
                        sel[p] = bi;
#pragma unroll
                        for (int i = 0; i < 16; ++i) gt[i] = (crow(i, hf) == bi) ? -INFINITY : gt[i]; }
                    if (hf == 0) {
#pragma unroll
                        for (int p = 0; p < 3; ++p) if (p < nsel) { const int n = sel[p];
                            const int lpos = __hip_atomic_fetch_add(lcn + n, 1, __ATOMIC_RELAXED, __HIP_MEMORY_SCOPE_WORKGROUP);
                            const int ei = __hip_atomic_fetch_add(lcn + 32, 1, __ATOMIC_RELAXED, __HIP_MEMORY_SCOPE_WORKGROUP);
                            ebuf[ei] = ((unsigned)n << 26) | ((unsigned)lpos << 15) | (unsigned)((t << 2) | p); } }
                }
#pragma unroll
                for (int s4 = 0; s4 < 4; ++s4) bq[s4] = bqn[s4];
            }
            asm volatile("s_waitcnt lgkmcnt(0)" ::: "memory");
            __syncthreads();
            if (tid < 32) { const int c = lcn[tid]; lcn[64 + tid] = c ? (int)atomicAdd(&ctl[CW_LCNT + bh * 32 + tid], (unsigned)c) : 0; }
            __syncthreads();
            { const int ne = lcn[32];
              for (int i = tid; i < ne; i += NTHR) { const unsigned e = ebuf[i]; const int n = (int)(e >> 26), lpos = (int)((e >> 15) & 2047u);
                  LST[(size_t)bh * LST_STRIDE + 256 * (31 * n - (n * (n - 1)) / 2) + lcn[64 + n] + lpos] = (unsigned short)(e & 32767u); } }
        }
    }
    GRID_BAR();

    for (int rep_ = 0; rep_ < REPN(2); ++rep_) {
    if (bx < 64 * GLA_NSPLIT) for (int rg_ = 0; rg_ < REPN(6); ++rg_) {
        PHASE_IDS
        const int seg = bx >> 6, b = (bx >> 4) & 3, h = (bx >> 2) & 3, es = bx & 3, n0 = seg * GLA_CPS;
        LAS unsigned char* Qg = lds;
        LAS unsigned char* Kg = lds + 17408;
        LAS unsigned char* KgT = lds + 34816;
        LAS unsigned char* VTl = lds + 53248;
        LAS unsigned char* STl = lds + 62464;
        LAS float* decl = (LAS float*)(lds + 79872);
        const int dp = tid & 63, c8 = wave, d0 = 2 * dp;
        const int r = lane & 31, hf = lane >> 5;
        for (int i = tid; i < 17408 / 4; i += NTHR) ((LAS unsigned*)STl)[i] = 0u;
        f32x16 sacc;
#pragma unroll
        for (int i = 0; i < 16; ++i) sacc[i] = 0.f;
        const int sdt = wave >> 1, set_ = wave & 1;
        const size_t tok0 = (size_t)b * SEQ;
        const float* decg = DEC + (size_t)(b * 4 + h) * 128 * 128;
        unsigned qrA[8], krA[8], qrB[8], krB[8], vrA[4], vrB[4]; float drA = 0.f, drB = 0.f;
        const int ep2 = (tid & 31) * 2, c16 = tid >> 5;
#define GLA_LOAD(n_, qr, kr, vr, dr) do { const size_t t0_ = tok0 + (size_t)(n_) * 64; \
            _Pragma("unroll") for (int i = 0; i < 8; ++i) { const size_t row_ = t0_ + c8 * 8 + i; \
                qr[i] = *(const unsigned*)(QBb + row_ * 512 + h * 128 + d0); kr[i] = *(const unsigned*)(KBb + row_ * 512 + h * 128 + d0); } \
            _Pragma("unroll") for (int i = 0; i < 4; ++i) vr[i] = *(const unsigned*)(VBb + (t0_ + c16 * 4 + i) * 1024 + h * 256 + es * 64 + ep2); \
            if (tid < 128) dr = decg[(size_t)(n_) * 128 + tid]; } while (0)
#define GLA_STAGE(qr, kr, vr, dr) do { \
            _Pragma("unroll") for (int i = 0; i < 8; ++i) { const int c = c8 * 8 + i; *(LAS unsigned*)(Qg + c * 272 + d0 * 2) = qr[i]; *(LAS unsigned*)(Kg + c * 272 + d0 * 2) = kr[i]; } \
            { u32x4 k0, k1; \
              k0.x = (kr[0] & 0xffffu) | (kr[1] << 16); k0.y = (kr[2] & 0xffffu) | (kr[3] << 16); k0.z = (kr[4] & 0xffffu) | (kr[5] << 16); k0.w = (kr[6] & 0xffffu) | (kr[7] << 16); \
              k1.x = (kr[0] >> 16) | (kr[1] & 0xffff0000u); k1.y = (kr[2] >> 16) | (kr[3] & 0xffff0000u); k1.z = (kr[4] >> 16) | (kr[5] & 0xffff0000u); k1.w = (kr[6] >> 16) | (kr[7] & 0xffff0000u); \
              *(LAS u32x4*)(KgT + d0 * 144 + c8 * 16) = k0; *(LAS u32x4*)(KgT + (d0 + 1) * 144 + c8 * 16) = k1; \
              *(LAS u32x2*)(VTl + ep2 * 144 + c16 * 8) = (u32x2){(vr[0] & 0xffffu) | (vr[1] << 16), (vr[2] & 0xffffu) | (vr[3] << 16)}; \
              *(LAS u32x2*)(VTl + (ep2 + 1) * 144 + c16 * 8) = (u32x2){(vr[0] >> 16) | (vr[1] & 0xffff0000u), (vr[2] >> 16) | (vr[3] & 0xffff0000u)}; } \
            if (tid < 128) decl[tid] = dr; } while (0)
        GLA_LOAD(n0, qrA, krA, vrA, drA);
        GLA_LOAD(n0 + 1, qrB, krB, vrB, drB);
#define GLA_OBODY(CT) do { \
                f32x16 oacc, X0, X1; \
                _Pragma("unroll") for (int i = 0; i < 16; ++i) { oacc[i] = 0.f; X0[i] = 0.f; X1[i] = 0.f; } \
                bf16x8 qa[8], sbv[8], ka0[8], ka1[8]; \
                _Pragma("unroll") for (int ks = 0; ks < 8; ++ks) { qa[ks] = *(const LAS bf16x8*)(Qg + ((CT) * 32 + r) * 272 + ks * 32 + hf * 16); \
                    sbv[ks] = *(const LAS bf16x8*)(STl + (et * 32 + r) * 272 + ks * 32 + hf * 16); \
                    ka0[ks] = *(const LAS bf16x8*)(Kg + r * 272 + ks * 32 + hf * 16); \
                    ka1[ks] = ((CT) == 1) ? *(const LAS bf16x8*)(Kg + (32 + r) * 272 + ks * 32 + hf * 16) : ka0[ks]; } \
                _Pragma("unroll") for (int ks = 0; ks < 8; ++ks) { \
                    oacc = __builtin_amdgcn_mfma_f32_32x32x16_bf16(qa[ks], sbv[ks], oacc, 0, 0, 0); \
                    X0 = __builtin_amdgcn_mfma_f32_32x32x16_bf16(ka0[ks], qa[ks], X0, 0, 0, 0); \
                    if ((CT) == 1) X1 = __builtin_amdgcn_mfma_f32_32x32x16_bf16(ka1[ks], qa[ks], X1, 0, 0, 0); } \
                _Pragma("unroll") for (int i = 0; i < 16; ++i) { const bool keep = crow(i, hf) <= r; if ((CT) == 0) X0[i] = keep ? X0[i] : 0.f; else X1[i] = keep ? X1[i] : 0.f; } \
                _Pragma("unroll") for (int s2 = 0; s2 < 2; ++s2) { \
                    { u32x4 pw; pw.x = cvtpk(X0[8 * s2 + 0], X0[8 * s2 + 1]); pw.y = cvtpk(X0[8 * s2 + 2], X0[8 * s2 + 3]); pw.z = cvtpk(X0[8 * s2 + 4], X0[8 * s2 + 5]); pw.w = cvtpk(X0[8 * s2 + 6], X0[8 * s2 + 7]); \
                      const LAS unsigned char* vp = VTl + (et * 32 + r) * 144 + (16 * s2 + 4 * hf) * 2; \
                      const u32x2 lo2 = *(const LAS u32x2*)vp, hi2 = *(const LAS u32x2*)(vp + 16); \
                      oacc = __builtin_amdgcn_mfma_f32_32x32x16_bf16(__builtin_bit_cast(bf16x8, pw), __builtin_bit_cast(bf16x8, (u32x4){lo2.x, lo2.y, hi2.x, hi2.y}), oacc, 0, 0, 0); } \
                    if ((CT) == 1) { u32x4 pw; pw.x = cvtpk(X1[8 * s2 + 0], X1[8 * s2 + 1]); pw.y = cvtpk(X1[8 * s2 + 2], X1[8 * s2 + 3]); pw.z = cvtpk(X1[8 * s2 + 4], X1[8 * s2 + 5]); pw.w = cvtpk(X1[8 * s2 + 6], X1[8 * s2 + 7]); \
                      const LAS unsigned char* vp = VTl + (et * 32 + r) * 144 + (32 + 16 * s2 + 4 * hf) * 2; \
                      const u32x2 lo2 = *(const LAS u32x2*)vp, hi2 = *(const LAS u32x2*)(vp + 16); \
                      oacc = __builtin_amdgcn_mfma_f32_32x32x16_bf16(__builtin_bit_cast(bf16x8, pw), __builtin_bit_cast(bf16x8, (u32x4){lo2.x, lo2.y, hi2.x, hi2.y}), oacc, 0, 0, 0); } } \
                bf16_t* op = yb + (tok0 + (size_t)n * 64 + (CT) * 32 + 4 * hf) * 1024 + h * 256 + es * 64 + et * 32 + r; \
                _Pragma("unroll") for (int i = 0; i < 16; ++i) op[(size_t)((i & 3) + 8 * (i >> 2)) * 1024] = (bf16_t)f2bf(oacc[i]); } while (0)
#define GLA_CHUNK(qr, kr, vr, dr) do { \
            GLA_STAGE(qr, kr, vr, dr); \
            LDS_BARRIER(); \
            if (wave < 4) { const int et = wave & 1; if ((wave >> 1) == 0) GLA_OBODY(0); else GLA_OBODY(1); } \
            if (n + 2 < n0 + GLA_CPS) GLA_LOAD(n + 2, qr, kr, vr, dr); \
            { bf16x8 ka[4], vb[4]; \
              _Pragma("unroll") for (int ks = 0; ks < 4; ++ks) { ka[ks] = *(const LAS bf16x8*)(KgT + (sdt * 32 + r) * 144 + ks * 32 + hf * 16); vb[ks] = *(const LAS bf16x8*)(VTl + (set_ * 32 + r) * 144 + ks * 32 + hf * 16); } \
              _Pragma("unroll") for (int ks = 0; ks < 4; ++ks) sacc = __builtin_amdgcn_mfma_f32_32x32x16_bf16(ka[ks], vb[ks], sacc, 0, 0, 0); } \
            _Pragma("unroll") for (int i = 0; i < 16; ++i) sacc[i] *= decl[sdt * 32 + crow(i, hf)]; \
            LDS_BARRIER(); \
            _Pragma("unroll") for (int i4 = 0; i4 < 4; ++i4) \
                *(LAS u32x2*)(STl + (set_ * 32 + r) * 272 + (sdt * 32 + 8 * i4 + 4 * hf) * 2) = (u32x2){cvtpk(sacc[4 * i4], sacc[4 * i4 + 1]), cvtpk(sacc[4 * i4 + 2], sacc[4 * i4 + 3])}; } while (0)
#pragma unroll 1
        for (int n = n0; n < n0 + GLA_CPS; ++n) {
            GLA_CHUNK(qrA, krA, vrA, drA);
            ++n;
            GLA_CHUNK(qrB, krB, vrB, drB);
        }
#undef GLA_CHUNK
#undef GLA_OBODY
        if (seg + 1 < GLA_NSPLIT) { float* sl = (float*)(ws + WS_SLOC) + ((size_t)(b * 4 + h) * 256 + es * 64 + set_ * 32 + r) * 128 + sdt * 32 + 4 * hf;
#pragma unroll
            for (int i4 = 0; i4 < 4; ++i4) *(f32x4*)(sl + 8 * i4) = (f32x4){sacc[4 * i4], sacc[4 * i4 + 1], sacc[4 * i4 + 2], sacc[4 * i4 + 3]}; }
#undef GLA_LOAD
#undef GLA_STAGE
        __syncthreads();
    }
    {
        if (GLA_NSPLIT == 2 && bx >= G - 4) { const int lane = threadIdx.x & 63, gw = (bx - (G - 4)) * NWAVES + (int)(threadIdx.x >> 6);
            const int bh4 = gw >> 1, d = (gw & 1) * 64 + lane; const float* dg = DEC + ((size_t)bh4 * 128 + 64) * 128 + d; float* pnp = (float*)(ws + WS_PN) + (size_t)bh4 * 64 * 128 + d;
            float p = 1.f;
#pragma unroll 1
            for (int n0 = 0; n0 < 64; n0 += 16) { float dv[16];
#pragma unroll
                for (int q = 0; q < 16; ++q) dv[q] = dg[(size_t)(n0 + q) * 128];
#pragma unroll
                for (int q = 0; q < 16; ++q) { pnp[(size_t)(n0 + q) * 128] = p; p *= dv[q]; } }
        }
    }
    for (int rm_ = 0; rm_ < REPN(7); ++rm_) {   PHASE_IDS
        LAS unsigned char* Kl = lds;
        LAS unsigned char* Vl = lds + 36864;
        LAS float* tabL = (LAS float*)(lds + 71680);
        LAS int* upre = (LAS int*)(lds + 92160);
        LAS int* cntL = (LAS int*)(lds + 92160 + 4128);
        LAS int* qinfo = (LAS int*)(lds + 102400) + wave * 32;
        LAS int* sch = (LAS int*)(lds + LDS_MISC);
        __syncthreads();
        { float tv[10];
#pragma unroll
          for (int j = 0; j < 10; ++j) { const int i = tid + j * NTHR, hh = i / 640, d = i % 640 - 255; tv[j] = tab[d < 0 ? 0 : (d < 128 ? hh * 128 + d : 1024 + hh)]; }
#pragma unroll
          for (int j = 0; j < 10; ++j) { const int i = tid + j * NTHR, d = i % 640 - 255; tabL[i] = d < 0 ? -INFINITY : tv[j]; } }
        if (wave == 0) {
            int loc[16]; int sum = 0;
#pragma unroll
            for (int q = 0; q < 16; ++q) { const int c = (int)ctl[CW_LCNT + lane * 16 + q]; cntL[lane * 16 + q] = c;        loc[q] = sum; sum += (256 + c + MB_CH - 1) / MB_CH; }
            int incl = sum;
            for (int off = 1; off < 64; off <<= 1) { const int o = __shfl_up(incl, off); if (lane >= off) incl += o; }
            const int excl = incl - sum;
#pragma unroll
            for (int q = 0; q < 16; ++q) upre[lane * 16 + q] = excl + loc[q];
            if (lane == 63) upre[1024] = incl;
        }
        __syncthreads();
        const int nunits = upre[1024];
        const int r = lane & 31, hf = lane >> 5;
        __syncthreads();
        if (tid == 0) sch[0] = (int)atomicAdd(&ctl[CW_QCTR + 64 * rep_ + 128 * rm_], 1u);
        __syncthreads();
        int li_c = 0, ch_c = 0; unsigned ent_c[4] = {0u, 0u, 0u, 0u};
#define MB_PREFETCH(unx) do { int lo_ = 0, hi_ = 1024;   \
            while (hi_ - lo_ > 1) { const int mid = (lo_ + hi_) >> 1; if (upre[mid] <= (unx)) lo_ = mid; else hi_ = mid; } \
            li_c = lo_; ch_c = (unx) - upre[lo_]; \
            { const int bh_ = li_c >> 5, n_ = li_c & 31, total_ = 256 + cntL[li_c], e0_ = ch_c * MB_CH, nent_ = (total_ - e0_) < MB_CH ? (total_ - e0_) : MB_CH, ngr_ = (nent_ + 31) >> 5; \
              const unsigned short* lp_ = LST + (size_t)bh_ * LST_STRIDE + 256 * (31 * n_ - (n_ * (n_ - 1)) / 2); \
              _Pragma("unroll") for (int g2 = 0; g2 < 4; ++g2) { const int eidx = e0_ + (wave + 8 * g2) * 32 + r; ent_c[g2] = 0u; \
                  if ((wave + 8 * g2 < ngr_) && eidx < total_ && eidx >= 256) ent_c[g2] = lp_[eidx - 256]; } } } while (0)
        { const int un0 = sch[0]; if (un0 < nunits) MB_PREFETCH(un0); }
        for (int uk_ = 0;; ++uk_) {
            const int un = sch[uk_ & 1];
            if (un >= nunits) break;
            unsigned nx_pop = 0u;
            if (tid == 0) nx_pop = atomicAdd(&ctl[CW_QCTR + 64 * rep_ + 128 * rm_], 1u);
            const int li = li_c, ch = ch_c, bh = li >> 5, n = li & 31, b = bh >> 3, h = bh & 7;
            const int total = 256 + cntL[li];
            const int e0 = ch * MB_CH, nent = (total - e0) < MB_CH ? (total - e0) : MB_CH, ngr = (nent + 31) >> 5;
            u32x4 kreg[4], vreg[4];
#pragma unroll
            for (int q = 0; q < 4; ++q) { const int idx = tid + q * NTHR; const int key = idx >> 3, c = idx & 7, dim = idx >> 5, kc = idx & 31;
                kreg[q] = *(const u32x4*)(Km + (size_t)(b * SEQ + n * 256 + key) * 512 + h * 64 + c * 8);
                vreg[q] = *(const u32x4*)(VT + ((size_t)bh * 64 + dim) * 8192 + n * 256 + kc * 8); }
            int tg[4], pg[4]; bool vg[4];
#pragma unroll
            for (int g2 = 0; g2 < 4; ++g2) { const int eidx = e0 + (wave + 8 * g2) * 32 + r; vg[g2] = (wave + 8 * g2 < ngr) && eidx < total; tg[g2] = n * 256; pg[g2] = 3;
                if (vg[g2]) { if (eidx < 256) tg[g2] = n * 256 + eidx; else { const unsigned ent = ent_c[g2]; tg[g2] = (int)(ent >> 2); pg[g2] = (int)(ent & 3u); } } }
            bf16x8 bq[4], bqn[4];
            { const bf16_t* qp = Qm + (size_t)(b * SEQ + tg[0]) * 512 + h * 64 + 8 * hf;
#pragma unroll
              for (int s4 = 0; s4 < 4; ++s4) { bq[s4] = *(const bf16x8*)(qp + 16 * s4); bqn[s4] = bq[s4]; } }
            __syncthreads();
            if (tid == 0) sch[(uk_ + 1) & 1] = (int)nx_pop;
#pragma unroll
            for (int q = 0; q < 4; ++q) { const int idx = tid + q * NTHR; const int key = idx >> 3, c = idx & 7, dim = idx >> 5, kc = idx & 31;
                *(LAS u32x4*)(Kl + key * 144 + (c << 4)) = kreg[q];
                *(LAS u32x2*)(Vl + dim * 520 + (kc << 4)) = (u32x2){vreg[q].x, vreg[q].y};
                *(LAS u32x2*)(Vl + dim * 520 + (kc << 4) + 8) = (u32x2){vreg[q].z, vreg[q].w}; }
            __syncthreads();
            { const int unn = sch[(uk_ + 1) & 1]; if (unn < nunits) MB_PREFETCH(unn); }
            const float t31 = tab[1024 + h];
            const LAS unsigned char* kbase = Kl + r * 144 + hf * 16; const LAS unsigned char* vbase = Vl + r * 520 + hf * 8;
#pragma unroll 1
            for (int g2 = 0; g2 < 4; ++g2) {
                if (wave + 8 * g2 >= ngr) break;
                const bool valid = g2 == 0 ? vg[0] : (g2 == 1 ? vg[1] : (g2 == 2 ? vg[2] : vg[3])); const int t = g2 == 0 ? tg[0] : (g2 == 1 ? tg[1] : (g2 == 2 ? tg[2] : tg[3])), part = g2 == 0 ? pg[0] : (g2 == 1 ? pg[1] : (g2 == 2 ? pg[2] : pg[3]));
                if (hf == 0) qinfo[r] = valid ? ((t << 2) | part) : -1;
                if (g2 < 3 && wave + 8 * (g2 + 1) < ngr) { const int tn = g2 == 0 ? tg[1] : (g2 == 1 ? tg[2] : tg[3]); const bf16_t* qp = Qm + (size_t)(b * SEQ + tn) * 512 + h * 64 + 8 * hf;
#pragma unroll
                    for (int s4 = 0; s4 < 4; ++s4) bqn[s4] = *(const bf16x8*)(qp + 16 * s4); }
                f32x16 st[8];
                {
                    bf16x8 ka[4], kn[4];
#pragma unroll
                    for (int s4 = 0; s4 < 4; ++s4) { ka[s4] = *(const LAS bf16x8*)(kbase + s4 * 32); kn[s4] = ka[s4]; }
#pragma unroll
                    for (int kt = 0; kt < 8; ++kt) {
#pragma unroll
                        for (int i = 0; i < 16; ++i) st[kt][i] = 0.f;
                        if (kt < 7) {
#pragma unroll
                            for (int s4 = 0; s4 < 4; ++s4) kn[s4] = *(const LAS bf16x8*)(kbase + (kt + 1) * 4608 + s4 * 32); }
#pragma unroll
                        for (int s4 = 0; s4 < 4; ++s4) st[kt] = __builtin_amdgcn_mfma_f32_32x32x16_bf16(ka[s4], bq[s4], st[kt], 0, 0, 0);
                        __builtin_amdgcn_sched_barrier(0);
#pragma unroll
                        for (int s4 = 0; s4 < 4; ++s4) ka[s4] = kn[s4];
                    }
                }
#pragma unroll
                for (int s4 = 0; s4 < 4; ++s4) bq[s4] = bqn[s4];
                const int rel = t - n * 256;
                const bool near = __any(valid && rel < 383);
                float cadd = t31;
                if (near) { cadd = 0.f;
                    const LAS float* tb = tabL + h * 640 + (rel < 383 ? rel : 383) - 4 * hf;
#pragma unroll
                    for (int kt = 0; kt < 8; ++kt)
#pragma unroll
                        for (int i = 0; i < 16; ++i) st[kt][i] += tb[255 - kt * 32 - (i & 3) - 8 * (i >> 2)]; }
                float mx = -INFINITY;
#pragma unroll
                for (int kt = 0; kt < 8; ++kt)
#pragma unroll
                    for (int i = 0; i < 16; ++i) mx = fmaxf(mx, st[kt][i]);
                mx = fmaxf(mx, __shfl_xor(mx, 32));
                float l = 0.f;
#pragma unroll
                for (int kt = 0; kt < 8; ++kt)
#pragma unroll
                    for (int i = 0; i < 16; ++i) { const float p = __expf(st[kt][i] - mx); st[kt][i] = p; l += p; }
                l += __shfl_xor(l, 32);
                f32x16 o0, o1;
#pragma unroll
                for (int i = 0; i < 16; ++i) { o0[i] = 0.f; o1[i] = 0.f; }
#pragma unroll
                for (int kt = 0; kt < 8; ++kt)
#pragma unroll
                    for (int s2 = 0; s2 < 2; ++s2) {
                        u32x4 pw; pw.x = cvtpk(st[kt][8 * s2 + 0], st[kt][8 * s2 + 1]); pw.y = cvtpk(st[kt][8 * s2 + 2], st[kt][8 * s2 + 3]);
                        pw.z = cvtpk(st[kt][8 * s2 + 4], st[kt][8 * s2 + 5]); pw.w = cvtpk(st[kt][8 * s2 + 6], st[kt][8 * s2 + 7]);
                        const bf16x8 pa = __builtin_bit_cast(bf16x8, pw);
#pragma unroll
                        for (int dt = 0; dt < 2; ++dt) {
                            const u32x2 lo2 = *(const LAS u32x2*)(vbase + dt * 16640 + kt * 64 + s2 * 32), hi2 = *(const LAS u32x2*)(vbase + dt * 16640 + kt * 64 + s2 * 32 + 16);
                            const bf16x8 vb = __builtin_bit_cast(bf16x8, (u32x4){lo2.x, lo2.y, hi2.x, hi2.y});
                            if (dt == 0) o0 = __builtin_amdgcn_mfma_f32_32x32x16_bf16(pa, vb, o0, 0, 0, 0); else o1 = __builtin_amdgcn_mfma_f32_32x32x16_bf16(pa, vb, o1, 0, 0, 0); }
                    }
                {
                    LAS unsigned char* ost = lds + 104448 + wave * 4608;
#pragma unroll
                    for (int i = 0; i < 16; ++i) { const int qrow = crow(i, hf);
                        *(LAS unsigned short*)(ost + qrow * 144 + r * 2) = (unsigned short)f2bf(o0[i]); *(LAS unsigned short*)(ost + qrow * 144 + 64 + r * 2) = (unsigned short)f2bf(o1[i]); }
                    asm volatile("s_waitcnt lgkmcnt(0)" ::: "memory");
                    if (valid) { const LAS u32x4* src = (const LAS u32x4*)(ost + r * 144 + hf * 64);
                        const float il = __builtin_amdgcn_rcpf(l); u32x4 q8[2];
#pragma unroll
                        for (int c = 0; c < 2; ++c) { const u32x4 a = src[2 * c], b2 = src[2 * c + 1]; int w0 = 0, w1 = 0, w2 = 0, w3 = 0;
                            w0 = __builtin_amdgcn_cvt_pk_fp8_f32(bflo(a.x) * il, bfhi(a.x) * il, w0, false); w0 = __builtin_amdgcn_cvt_pk_fp8_f32(bflo(a.y) * il, bfhi(a.y) * il, w0, true);
                            w1 = __builtin_amdgcn_cvt_pk_fp8_f32(bflo(a.z) * il, bfhi(a.z) * il, w1, false); w1 = __builtin_amdgcn_cvt_pk_fp8_f32(bflo(a.w) * il, bfhi(a.w) * il, w1, true);
                            w2 = __builtin_amdgcn_cvt_pk_fp8_f32(bflo(b2.x) * il, bfhi(b2.x) * il, w2, false); w2 = __builtin_amdgcn_cvt_pk_fp8_f32(bflo(b2.y) * il, bfhi(b2.y) * il, w2, true);
                            w3 = __builtin_amdgcn_cvt_pk_fp8_f32(bflo(b2.z) * il, bfhi(b2.z) * il, w3, false); w3 = __builtin_amdgcn_cvt_pk_fp8_f32(bflo(b2.w) * il, bfhi(b2.w) * il, w3, true);
                            q8[c] = (u32x4){(unsigned)w0, (unsigned)w1, (unsigned)w2, (unsigned)w3}; }
                        u32x4* dst = (u32x4*)(PO8 + (((size_t)bh * SEQ + t) * 4 + part) * 64 + hf * 32);
                        dst[0] = q8[0]; dst[1] = q8[1]; }
                }
                if (hf == 0 && valid) { float* mp = ML + (((size_t)bh * SEQ + t) * 4 + part) * 2; mp[0] = mx + cadd; mp[1] = l; }
                asm volatile("s_waitcnt lgkmcnt(0)" ::: "memory");
            }
        }
#undef MB_PREFETCH
    }
    GRID_BAR();
    }

    { PHASE_IDS
    INP(gla_norm, 9);
#pragma unroll 2
    for (int it0 = gw * 16; it0 < 32 * SEQ; it0 += NGW * 16) {
        const int it = it0 + (lane >> 2), dl = lane & 3;
        const int bh = it >> 13, t = it & (SEQ - 1), b = bh >> 3, h = bh & 7, j = t >> 8, nsel = j < 3 ? j : 3;
        const f32x4 m01 = *(const f32x4*)(ML + (size_t)it * 8), m23 = *(const f32x4*)(ML + (size_t)it * 8 + 4);
        const unsigned char* pr = PO8 + (size_t)it * 256 + dl * 16;
        const u32x4 p0 = *(const u32x4*)pr, p1 = *(const u32x4*)(pr + 64), p2 = *(const u32x4*)(pr + 128), p3 = *(const u32x4*)(pr + 192);
#define PO_DEC4(p) ([&] { const f32x2_t lo_ = __builtin_amdgcn_cvt_pk_f32_fp8((int)(p), false), hi_ = __builtin_amdgcn_cvt_pk_f32_fp8((int)(p), true); return (f32x4){lo_[0], lo_[1], hi_[0], hi_[1]}; }())
#define PO_ACC(p, wl) do { o[0] += PO_DEC4((p).x) * (wl); o[1] += PO_DEC4((p).y) * (wl); o[2] += PO_DEC4((p).z) * (wl); o[3] += PO_DEC4((p).w) * (wl); } while (0)
        float M = m23[2];
        if (nsel > 0) M = fmaxf(M, m01[0]); if (nsel > 1) M = fmaxf(M, m01[2]); if (nsel > 2) M = fmaxf(M, m23[0]);
        const float w3 = __expf(m23[2] - M), w0 = nsel > 0 ? __expf(m01[0] - M) : 0.f, w1 = nsel > 1 ? __expf(m01[2] - M) : 0.f, w2 = nsel > 2 ? __expf(m23[0] - M) : 0.f;
        float den = w3 * m23[3]; f32x4 o[4] = {PO_DEC4(p3.x) * den, PO_DEC4(p3.y) * den, PO_DEC4(p3.z) * den, PO_DEC4(p3.w) * den};
        if (nsel > 0) { const float wl = w0 * m01[1]; den += wl; PO_ACC(p0, wl); }
        if (nsel > 1) { const float wl = w1 * m01[3]; den += wl; PO_ACC(p1, wl); }
        if (nsel > 2) { const float wl = w2 * m23[1]; den += wl; PO_ACC(p2, wl); }
#undef PO_ACC
#undef PO_DEC4
        const float inv = 1.f / den;
        { int w8[4];
#pragma unroll
          for (int k = 0; k < 4; ++k) { int w = 0; w = __builtin_amdgcn_cvt_pk_fp8_f32(o[k][0] * inv, o[k][1] * inv, w, false); w = __builtin_amdgcn_cvt_pk_fp8_f32(o[k][2] * inv, o[k][3] * inv, w, true); w8[k] = w; }
          *(u32x4*)(ws + WS_YA8 + (size_t)(b * SEQ + t) * 512 + h * 64 + dl * 16) = (u32x4){(unsigned)w8[0], (unsigned)w8[1], (unsigned)w8[2], (unsigned)w8[3]}; }
    }
#pragma unroll 2
    for (int i0 = gw; i0 < 4 * GLA_CPS * 64; i0 += NGW) {
        const int m = (i0 / (GLA_CPS * 64)) * SEQ + (i0 % (GLA_CPS * 64));
        u32x4* yp = (u32x4*)(yb + (size_t)m * 1024 + lane * 16); const u32x4* rp = (const u32x4*)(Rb + (size_t)m * 1024 + lane * 16);
        const u32x4 a0 = yp[0], a1 = yp[1], r0 = rp[0], r1 = rp[1];
        float v[16] = {bflo(a0.x), bfhi(a0.x), bflo(a0.y), bfhi(a0.y), bflo(a0.z), bfhi(a0.z), bflo(a0.w), bfhi(a0.w), bflo(a1.x), bfhi(a1.x), bflo(a1.y), bfhi(a1.y), bflo(a1.z), bfhi(a1.z), bflo(a1.w), bfhi(a1.w)};
        const float g[16] = {bflo(r0.x), bfhi(r0.x), bflo(r0.y), bfhi(r0.y), bflo(r0.z), bfhi(r0.z), bflo(r0.w), bfhi(r0.w), bflo(r1.x), bfhi(r1.x), bflo(r1.y), bfhi(r1.y), bflo(r1.z), bfhi(r1.z), bflo(r1.w), bfhi(r1.w)};
        float ss = 0.f;
#pragma unroll
        for (int i = 0; i < 16; ++i) ss += v[i] * v[i];
        ss += __shfl_xor(ss, 1); ss += __shfl_xor(ss, 2); ss += __shfl_xor(ss, 4); ss += __shfl_xor(ss, 8);
        const float rs = rsqrtf(ss * (1.f / 256.f) + 1e-6f); const float* gn = gla_norm + (lane & 15) * 16;
#pragma unroll
        for (int i = 0; i < 16; ++i) v[i] = v[i] * rs * gn[i] * g[i];
        { int w0 = 0, w1 = 0, w2 = 0, w3 = 0;
          w0 = __builtin_amdgcn_cvt_pk_fp8_f32(v[0], v[1], w0, false); w0 = __builtin_amdgcn_cvt_pk_fp8_f32(v[2], v[3], w0, true); w1 = __builtin_amdgcn_cvt_pk_fp8_f32(v[4], v[5], w1, false); w1 = __builtin_amdgcn_cvt_pk_fp8_f32(v[6], v[7], w1, true);
          w2 = __builtin_amdgcn_cvt_pk_fp8_f32(v[8], v[9], w2, false); w2 = __builtin_amdgcn_cvt_pk_fp8_f32(v[10], v[11], w2, true); w3 = __builtin_amdgcn_cvt_pk_fp8_f32(v[12], v[13], w3, false); w3 = __builtin_amdgcn_cvt_pk_fp8_f32(v[14], v[15], w3, true);
          *(u32x4*)(ws + WS_YB8 + (size_t)m * 1024 + lane * 16) = (u32x4){(unsigned)w0, (unsigned)w1, (unsigned)w2, (unsigned)w3}; }
    }
    {
        constexpr int NCH1 = 128 - GLA_CPS, CG = 4, NCG = NCH1 / CG;
        LAS float* Ot = (LAS float*)lds;
        const int r = lane & 31, hf = lane >> 5;
        const float* slT = (const float*)(ws + WS_SLOC);
        for (int it = vcu; it < 16 * NCG; it += G) {
            const int bh = it / NCG, cg = it % NCG, b = bh >> 2, h = bh & 3;
            const int ct = wave & 1, et0 = (wave >> 1) * 2;
            bf16x8 sb[2][8];
#pragma unroll
            for (int tt = 0; tt < 2; ++tt) { const float* sp = slT + ((size_t)bh * 256 + (et0 + tt) * 32 + r) * 128 + 8 * hf;
#pragma unroll
                for (int ks = 0; ks < 8; ++ks) { const f32x4 x0 = *(const f32x4*)(sp + 16 * ks), x1 = *(const f32x4*)(sp + 16 * ks + 4);
                    sb[tt][ks] = __builtin_bit_cast(bf16x8, (u32x4){cvtpk(x0[0], x0[1]), cvtpk(x0[2], x0[3]), cvtpk(x1[0], x1[1]), cvtpk(x1[2], x1[3])}); } }
            const f32x4 gn4 = *(const f32x4*)(gla_norm + lane * 4);
#pragma unroll 1
            for (int c = 0; c < CG; ++c) {
                const int n = GLA_CPS + cg * CG + c;
                const size_t t0 = (size_t)b * SEQ + (size_t)n * 64;
                u32x4 qraw[8]; f32x4 pn0[8], pn1[8]; u32x2 rr[8], yl[8];
                { const bf16_t* qp = QBb + (t0 + ct * 32 + r) * 512 + h * 128 + 8 * hf; const float* pp = (const float*)(ws + WS_PN) + ((size_t)bh * 64 + (n - GLA_CPS)) * 128 + 8 * hf;
#pragma unroll
                  for (int ks = 0; ks < 8; ++ks) { qraw[ks] = *(const u32x4*)(qp + 16 * ks); pn0[ks] = *(const f32x4*)(pp + 16 * ks); pn1[ks] = *(const f32x4*)(pp + 16 * ks + 4); } }
#pragma unroll
                for (int q = 0; q < 8; ++q) { rr[q] = *(const u32x2*)(Rb + (t0 + wave * 8 + q) * 1024 + h * 256 + lane * 4); yl[q] = *(const u32x2*)(yb + (t0 + wave * 8 + q) * 1024 + h * 256 + lane * 4); }
                bf16x8 qa[8];
#pragma unroll
                for (int ks = 0; ks < 8; ++ks) { const u32x4 w = qraw[ks];
                    qa[ks] = __builtin_bit_cast(bf16x8, (u32x4){cvtpk(bflo(w.x) * pn0[ks][0], bfhi(w.x) * pn0[ks][1]), cvtpk(bflo(w.y) * pn0[ks][2], bfhi(w.y) * pn0[ks][3]),
                                                               cvtpk(bflo(w.z) * pn1[ks][0], bfhi(w.z) * pn1[ks][1]), cvtpk(bflo(w.w) * pn1[ks][2], bfhi(w.w) * pn1[ks][3])}); }
                __syncthreads();
#pragma unroll
                for (int tt = 0; tt < 2; ++tt) {
                    f32x16 a0;
#pragma unroll
                    for (int i = 0; i < 16; ++i) a0[i] = 0.f;
#pragma unroll
                    for (int ks = 0; ks < 8; ++ks) a0 = __builtin_amdgcn_mfma_f32_32x32x16_bf16(qa[ks], sb[tt][ks], a0, 0, 0, 0);
#pragma unroll
                    for (int i = 0; i < 16; ++i) Ot[(ct * 32 + crow(i, hf)) * 260 + (et0 + tt) * 32 + r] = a0[i];
                }
                __syncthreads();
#pragma unroll
                for (int q = 0; q < 8; ++q) { const int cr = wave * 8 + q; f32x4 o4 = *(const LAS f32x4*)(Ot + cr * 260 + lane * 4);
                    o4 += (f32x4){bflo(yl[q].x), bfhi(yl[q].x), bflo(yl[q].y), bfhi(yl[q].y)};
                    const float rs = rsqrtf(wave_sum((o4[0] * o4[0] + o4[1] * o4[1]) + (o4[2] * o4[2] + o4[3] * o4[3])) * (1.f / 256.f) + 1e-6f);
                    { int w8 = 0; w8 = __builtin_amdgcn_cvt_pk_fp8_f32(o4[0] * rs * gn4[0] * bflo(rr[q].x), o4[1] * rs * gn4[1] * bfhi(rr[q].x), w8, false);
                      w8 = __builtin_amdgcn_cvt_pk_fp8_f32(o4[2] * rs * gn4[2] * bflo(rr[q].y), o4[3] * rs * gn4[3] * bfhi(rr[q].y), w8, true);
                      *(unsigned*)(ws + WS_YB8 + (t0 + cr) * 1024 + h * 256 + lane * 4) = (unsigned)w8; } }
            }
            __syncthreads();
        }
    }
    }
    GRID_BAR();

    {
        const int rot = (bx & 7) % 3;
#pragma unroll 1
        for (int step = 0; step < 3; ++step) {
            if (step == rot) {
                PHASE_IDS
                INP(w_gate, 16); INP(w_up, 18);
                convert_items(32 * 16 * 64, gw, NGW, scr, lane, [=](int it) -> CvItem {
                    const int e = it >> 10, q = it & 1023, kb = q >> 6, nb = q & 63;
                    const int dr0 = nb * 32, pn = dr0 >> 8, bj = (dr0 >> 7) & 1, cc = dr0 & 127;
                    const float* src = (bj ? w_up : w_gate) + (size_t)e * 1024 * 1024;
                    return CvItem{src + (size_t)(kb * 64) * 1024 + pn * 128 + cc, (bf16_t*)((unsigned char*)WguT + (size_t)e * 2048 * 1024 + (size_t)dr0 * 1024 + kb * 64), 1024, 1024, 32, 32.f}; });
            } else if (step - (step > rot ? 1 : 0) == 0) {
                pg8::DenseOrder S; S.init(TT, 1024, G, bx, ws + WS_YA8, 256, WpaT, 256); S.reps = REPN(4); EpiMix<0> E{(const unsigned char*)GT, MIX};
                pg8::gemm_phase<EpiMix<0>, pg8::DenseOrder, false, 256, 256, 4, true>(lds, S, E);
            } else {
                pg8::DenseOrder S; S.init(TT, 1024, G, bx, ws + WS_YB8, 512, WpbT, 512); S.reps = REPN(4); EpiMix<1> E{(const unsigned char*)GT, MIX};
                pg8::gemm_phase<EpiMix<1>, pg8::DenseOrder, false, 512, 512, 8, true>(lds, S, E);
            }
            asm volatile("s_waitcnt vmcnt(0)" ::: "memory"); __syncthreads();
        }
    }
    GRID_BAR();

    {
#pragma unroll 1
        for (int step = 0; step < 2; ++step) {
            if (step == (bx & 1)) {
                INP(x, 0);
                pg8::DenseOrder S; S.init(TT, 1024, G, bx, ws + WS_MIX8, 512, WoutT, 512); S.reps = REPN(4); EpiX1 E{x, ws};
                pg8::gemm_phase<EpiX1, pg8::DenseOrder, false, 512, 512, 8, true>(lds, S, E);
            } else {
                PHASE_IDS
                INP(w_down, 20);
                convert_items(32 * 16 * 32, gw, NGW, scr, lane, [=](int it) -> CvItem { const int e = it / 512, q = it % 512, kb = q / 32, nb = q % 32;
                    return CvItem{w_down + (size_t)e * 1024 * 1024 + (size_t)(kb * 64) * 1024 + nb * 32, (bf16_t*)((unsigned char*)WdT + (size_t)e * 1024 * 1024 + (size_t)(nb * 32) * 1024 + kb * 64), 1024, 1024, 32, 32.f}; });
            }
            asm volatile("s_waitcnt vmcnt(0)" ::: "memory"); __syncthreads();
        }
    }
    GRID_BAR();

    {
        PHASE_IDS
        INP(norm_ffn, 13); INP(w_router, 14); INP(b_router, 15);
        LAS unsigned char* wf = lds;
        LAS float* pP = (LAS float*)(lds + LDS_IDX);
        LAS float* pS = pP + 1024;
        LAS float* cbl = pS + 1024;
        LAS int* lcnt = (LAS int*)(cbl + 64);
        LAS int* asg = lcnt + 64;
        int curb = -1;
        for (int t0 = vcu * NWAVES; t0 < TT / 16; t0 += G * NWAVES) {
            const int tidL = fresh_tid(), lane_ = tidL & 63;
            const int t = lane_ & 15, kq = lane_ >> 4;
            const int bb = (t0 * 16) >> 13;
            __syncthreads();
            if (bb != curb) { curb = bb;
#pragma unroll
                for (int q = 0; q < 2; ++q) { const int k = tidL + q * NTHR; pP[k] = norm_ffn[k] * (1.f + mod[bb * 6144 + 4096 + k]); pS[k] = mod[bb * 6144 + 3072 + k]; }
                __syncthreads();
                { f32x4 wv[16];
#pragma unroll
                  for (int q = 0; q < 16; ++q) wv[q] = *(const f32x4*)(w_router + (size_t)(q * NTHR + tidL) * 4);
#pragma unroll
                  for (int q = 0; q < 16; ++q) { const int i4 = q * NTHR + tidL, k = i4 >> 3, e0 = (i4 & 7) * 4; const float pk_ = pP[k];
                      const int s_ = k >> 5, kq_ = (k >> 3) & 3, ii = k & 7;
#pragma unroll
                      for (int j = 0; j < 4; ++j) { const int e = e0 + j, nt = e >> 4, n = e & 15; const float v = pk_ * wv[q][j];
                          const unsigned hb = f2bf(v), lb = f2bf(v - __builtin_bit_cast(float, hb << 16));
                          LAS unsigned short* dstp = (LAS unsigned short*)(wf + ((size_t)((s_ * 2 + nt) * 2) * 64 + (n + 16 * kq_)) * 16 + ii * 2);
                          dstp[0] = (unsigned short)hb; dstp[512] = (unsigned short)lb; } } }
                { float part[4] = {0.f, 0.f, 0.f, 0.f};
#pragma unroll
                  for (int i = 0; i < 16; ++i) { const int k = lane_ + 64 * i; const f32x4 w4 = *(const f32x4*)(w_router + (size_t)k * 32 + 4 * wave); const float sh = pS[k];
                      part[0] += sh * w4[0]; part[1] += sh * w4[1]; part[2] += sh * w4[2]; part[3] += sh * w4[3]; }
#pragma unroll
                  for (int j = 0; j < 4; ++j) { const float sm = wave_sum(part[j]); if (lane_ == 0) cbl[4 * wave + j] = sm + b_router[4 * wave + j]; } }
            }
            if (tidL < 32) lcnt[tidL] = 0;
            __syncthreads();
            {
                const int row = (t0 + wave) * 16 + t;
                const bf16_t* x1b = (const bf16_t*)(ws + WS_X1);
                const bf16_t* xr = x1b + (size_t)row * DM + 8 * kq;
                f32x4 acc0 = {0.f, 0.f, 0.f, 0.f}, acc1 = {0.f, 0.f, 0.f, 0.f}; float ss = 0.f;
                u32x4 ca[8], cn[8];
#pragma unroll
                for (int u = 0; u < 8; ++u) ca[u] = *(const u32x4*)(xr + 32 * u);
#pragma unroll
                for (int c = 0; c < 4; ++c) {
                    if (c < 3) {
#pragma unroll
                        for (int u = 0; u < 8; ++u) cn[u] = *(const u32x4*)(xr + 32 * (8 * c + 8 + u)); }
                    __builtin_amdgcn_sched_barrier(0);
#pragma unroll
                    for (int u = 0; u < 8; ++u) { const int s_ = 8 * c + u; const u32x4 w = ca[u];
                        const LAS unsigned char* wp = wf + (size_t)s_ * 4096 + lane_ * 16;
                        const bf16x8 wh0 = *(const LAS bf16x8*)wp, wl0 = *(const LAS bf16x8*)(wp + 1024), wh1 = *(const LAS bf16x8*)(wp + 2048), wl1 = *(const LAS bf16x8*)(wp + 3072);
                        { const float a0 = bflo(w.x), a1 = bfhi(w.x), a2 = bflo(w.y), a3 = bfhi(w.y), a4 = bflo(w.z), a5 = bfhi(w.z), a6 = bflo(w.w), a7 = bfhi(w.w);
                          ss += (a0 * a0 + a1 * a1) + (a2 * a2 + a3 * a3) + (a4 * a4 + a5 * a5) + (a6 * a6 + a7 * a7); }
                        const bf16x8 ah = __builtin_bit_cast(bf16x8, w);
                        acc0 = __builtin_amdgcn_mfma_f32_16x16x32_bf16(wh0, ah, acc0, 0, 0, 0); acc1 = __builtin_amdgcn_mfma_f32_16x16x32_bf16(wh1, ah, acc1, 0, 0, 0);
                        acc0 = __builtin_amdgcn_mfma_f32_16x16x32_bf16(wl0, ah, acc0, 0, 0, 0); acc1 = __builtin_amdgcn_mfma_f32_16x16x32_bf16(wl1, ah, acc1, 0, 0, 0);
                        __builtin_amdgcn_sched_barrier(0); }
#pragma unroll
                    for (int u = 0; u < 8; ++u) ca[u] = cn[u];
                }
                ss += __shfl_xor(ss, 16); ss += __shfl_xor(ss, 32);
                const float rs = rsqrtf(ss * (1.f / DM) + 1e-6f);
                float cand[8];
#pragma unroll
                for (int i = 0; i < 4; ++i) { cand[i] = rs * acc0[i] + cbl[4 * kq + i]; cand[4 + i] = rs * acc1[i] + cbl[16 + 4 * kq + i]; }
                int sel[4]; float val[4];
#pragma unroll
                for (int p = 0; p < 4; ++p) { float best = -INFINITY; int bi = 64;
#pragma unroll
                    for (int c = 0; c < 8; ++c) { const int e = (c < 4) ? 4 * kq + c : 12 + 4 * kq + c; if (cand[c] > best) { best = cand[c]; bi = e; } }
#pragma unroll
                    for (int off = 16; off < 64; off <<= 1) { const float ob = __shfl_xor(best, off); const int oi = __shfl_xor(bi, off); if (ob > best || (ob == best && oi < bi)) { best = ob; bi = oi; } }
                    sel[p] = bi; val[p] = best;
#pragma unroll
                    for (int c = 0; c < 8; ++c) { const int e = (c < 4) ? 4 * kq + c : 12 + 4 * kq + c; if (e == bi) cand[c] = -INFINITY; } }
                { const float e1 = __expf(val[1] - val[0]), e2 = __expf(val[2] - val[0]), e3 = __expf(val[3] - val[0]); const float inv = 1.f / (1.f + e1 + e2 + e3);
                  const float wk = (kq == 0 ? 1.f : (kq == 1 ? e1 : (kq == 2 ? e2 : e3))) * inv;
                  const int ek = kq == 0 ? sel[0] : (kq == 1 ? sel[1] : (kq == 2 ? sel[2] : sel[3]));
                  topw[row * 4 + kq] = wk;
                  const int lp = __hip_atomic_fetch_add(lcnt + ek, 1, __ATOMIC_RELAXED, __HIP_MEMORY_SCOPE_WORKGROUP);
                  const int slot = (wave * 16 + t) * 4 + kq;
                  asg[slot * 2] = (ek << 16) | lp; asg[slot * 2 + 1] = row * 4 + kq; }
                __builtin_amdgcn_sched_barrier(0);
                unsigned char* hrow = (unsigned char*)H2 + (size_t)row * DM + 8 * kq;
                const bf16_t* xr2 = x1b + (size_t)row * DM + 8 * kq;
                u32x4 da[8], dn[8];
#pragma unroll
                for (int u = 0; u < 8; ++u) da[u] = *(const u32x4*)(xr2 + 32 * u);
#pragma unroll 1
                for (int c = 0; c < 4; ++c) {
                    { const int cnx = c < 3 ? c + 1 : c;
#pragma unroll
                      for (int u = 0; u < 8; ++u) dn[u] = *(const u32x4*)(xr2 + 32 * (8 * cnx + u)); }
#pragma unroll
                    for (int u = 0; u < 8; ++u) { const int s_ = 8 * c + u; const LAS float* pp = pP + 32 * s_ + 8 * kq; const LAS float* sp = pS + 32 * s_ + 8 * kq;
                        const f32x4 p0 = *(const LAS f32x4*)pp, p1 = *(const LAS f32x4*)(pp + 4), s0 = *(const LAS f32x4*)sp, s1 = *(const LAS f32x4*)(sp + 4);
                        const u32x4 w = da[u];
                        const f32x4 h0 = (f32x4){bflo(w.x), bfhi(w.x), bflo(w.y), bfhi(w.y)} * rs * p0 + s0, h1 = (f32x4){bflo(w.z), bfhi(w.z), bflo(w.w), bfhi(w.w)} * rs * p1 + s1;
                        int w0 = 0, w1 = 0;
                        w0 = __builtin_amdgcn_cvt_pk_fp8_f32(h0[0], h0[1], w0, false); w0 = __builtin_amdgcn_cvt_pk_fp8_f32(h0[2], h0[3], w0, true);
                        w1 = __builtin_amdgcn_cvt_pk_fp8_f32(h1[0], h1[1], w1, false); w1 = __builtin_amdgcn_cvt_pk_fp8_f32(h1[2], h1[3], w1, true);
                        *(u32x2*)(hrow + 32 * s_) = (u32x2){(unsigned)w0, (unsigned)w1}; }
#pragma unroll
                    for (int u = 0; u < 8; ++u) da[u] = dn[u];
                }
            }
            asm volatile("s_waitcnt lgkmcnt(0)" ::: "memory");
            __syncthreads();
            if (tidL < 32) { const int c = lcnt[tidL]; lcnt[tidL] = c ? (int)atomicAdd(&ctl[CW_CNT + tidL], (unsigned)c) : 0; }
            __syncthreads();
            for (int sl = tidL; sl < 16 * NWAVES * 4; sl += NTHR) { const int pk = asg[sl * 2], a_ = asg[sl * 2 + 1]; const int e_ = pk >> 16, lp_ = pk & 0xffff; list[(size_t)e_ * TT + lcnt[e_] + lp_] = a_; }
        }
    }
    GRID_BAR();

    {
        PHASE_IDS
        LAS int* blkE = (LAS int*)(lds + LDS_BLKE);
        INP(b_gate, 17); INP(b_up, 19); INP(b_down, 21); INP(norm_final, 22); LAS int* blkR = (LAS int*)(lds + LDS_BLKR); LAS int* idxT = (LAS int*)(lds + LDS_IDX); LAS int* misc = (LAS int*)(lds + LDS_MISC);
        if (wave == 0) {
            const int c = (lane < 32) ? (int)ctl[CW_CNT + (lane & 31)] : 0; const int k = (c + 255) >> 8;
            if (lane < 32) misc[16 + lane] = c;
            int incl = k;
#pragma unroll
            for (int off = 1; off < 32; off <<= 1) { const int o = __shfl_up(incl, off); if (lane >= off) incl += o; }
            const int base = incl - k;
            for (int q = 0; q < k; ++q) { blkE[base + q] = lane; blkR[base + q] = q * 256; }
            if (lane == 31) misc[1] = incl; }
        __syncthreads();
        const int nb = misc[1];
        const int cp = vcu;
        pg8::MoeOrder<true, 8, 1024> S1{0, nb, G, cp, (const char*)H2, (const char*)WguT, blkE, idxT};
        {
            int av[9];
#pragma unroll
            for (int k = 0; k < 9; ++k) { const int idx = tid + k * NTHR, i = idx >> 8, rr = idx & 255; pg8::Unit u; av[k] = 0;
                if (S1.next(i, u)) { const int r = blkR[u.pm] + rr; const bool ok = r < misc[16 + u.e]; av[k] = list[(size_t)u.e * TT + (ok ? r : 0)]; } }
#pragma unroll
            for (int k = 0; k < 9; ++k) { const int idx = tid + k * NTHR, i = idx >> 8, rr = idx & 255; pg8::Unit u;
                if (S1.next(i, u)) { const int r = blkR[u.pm] + rr; const bool ok = r < misc[16 + u.e]; const int a = av[k];
                    idxT[idx] = a >> 2;
                    if (ok && u.pn == 0) dest[a] = u.pm * 256 + rr; } }
        }
        __syncthreads();
        { EpiAct E{b_gate, b_up, (unsigned char*)ACT};
          pg8::gemm_phase<EpiAct, pg8::MoeOrder<true, 8, 1024>, true, 512, 512, 8, true>(lds, S1, E); }
        GRID_BAR();
        { pg8::MoeOrder<false, 4, 1024> S2{0, nb, G, cp, (const char*)ACT, (const char*)WdT, blkE, idxT}; EpiDown E{b_down, (unsigned char*)YA, 0};
          pg8::gemm_phase<EpiDown, pg8::MoeOrder<false, 4, 1024>, false, 512, 512, 8, true>(lds, S2, E); }
        GRID_BAR();
        {
            int dA[4]; float wA[4]; u32x2 xA[4];
            const bf16_t* x1b = (const bf16_t*)(ws + WS_X1);
            float wN[4], wC[4]; f32x4 xN[4], xC[4], gN[4], gC[4]; unsigned yN[4][4], yC[4][4];
            f32x4 nf[4];
#pragma unroll
            for (int j = 0; j < 4; ++j) nf[j] = *(const f32x4*)(norm_final + 256 * j + 4 * lane);
#define P11_LOADA(m_) do { _Pragma("unroll") for (int k = 0; k < 4; ++k) { dA[k] = dest[(m_) * 4 + k]; wA[k] = topw[(m_) * 4 + k]; } \
                const u32x2* xr_ = (const u32x2*)(x1b + (size_t)(m_) * DM) + lane; _Pragma("unroll") for (int j = 0; j < 4; ++j) xA[j] = xr_[64 * j]; } while (0)
#define P11_LOADB(m_, Y, W, X, Gt) do { _Pragma("unroll") for (int k = 0; k < 4; ++k) { W[k] = wA[k]; const unsigned* y2 = (const unsigned*)((const unsigned char*)YA + (size_t)dA[k] * 1024) + lane; \
                    _Pragma("unroll") for (int j = 0; j < 4; ++j) Y[k][j] = y2[64 * j]; } \
                _Pragma("unroll") for (int j = 0; j < 4; ++j) { X[j] = (f32x4){bflo(xA[j].x), bfhi(xA[j].x), bflo(xA[j].y), bfhi(xA[j].y)}; Gt[j] = *(const f32x4*)(mod + ((m_) >> 13) * 6144 + 5120 + 256 * j + 4 * lane); } } while (0)
            const int last = gw + ((TT - 1 - gw) / NGW) * NGW;
            P11_LOADA(gw);
            P11_LOADB(gw, yC, wC, xC, gC);
            { const int m1 = (gw + NGW <= last) ? gw + NGW : last; P11_LOADA(m1); }
            for (int m = gw; m < TT; m += NGW) {
                { const int m1 = (m + NGW <= last) ? m + NGW : last; P11_LOADB(m1, yN, wN, xN, gN); }
                { const int m2 = (m + 2 * NGW <= last) ? m + 2 * NGW : last; P11_LOADA(m2); }
                f32x4 v[4];
#pragma unroll
                for (int j = 0; j < 4; ++j) { v[j] = (f32x4){0.f, 0.f, 0.f, 0.f};
#pragma unroll
                    for (int k = 0; k < 4; ++k) { const unsigned p = yC[k][j]; const f32x2_t lo = __builtin_amdgcn_cvt_pk_f32_fp8((int)p, false), hi = __builtin_amdgcn_cvt_pk_f32_fp8((int)p, true);
                        v[j] += (f32x4){lo[0], lo[1], hi[0], hi[1]} * wC[k]; } }
                float s2 = 0.f;
#pragma unroll
                for (int j = 0; j < 4; ++j) { v[j] = xC[j] + gC[j] * v[j]; s2 += (v[j][0] * v[j][0] + v[j][1] * v[j][1]) + (v[j][2] * v[j][2] + v[j][3] * v[j][3]); }
                const float rs = rsqrtf(wave_sum(s2) * (1.f / DM) + 1e-6f);
                f32x4* xw = (f32x4*)(out + (size_t)m * DM) + lane;
#pragma unroll
                for (int j = 0; j < 4; ++j) xw[64 * j] = v[j] * rs * nf[j];
#pragma unroll
                for (int k = 0; k < 4; ++k) { wC[k] = wN[k];
#pragma unroll
                    for (int j = 0; j < 4; ++j) yC[k][j] = yN[k][j]; }
#pragma unroll
                for (int j = 0; j < 4; ++j) { xC[j] = xN[j]; gC[j] = gN[j]; }
            }
#undef P11_LOADA
#undef P11_LOADB
        }
    }
#if PROBE >= 10
    GRID_BAR();
    if (blockIdx.x == 0) {
        volatile unsigned* tsl = (volatile unsigned*)(args.ws + WS_CTL) + 15000;
        const float ta = (float)(tsl[PROBE_A1] - tsl[PROBE_A0]) * 0.01f, tr = (float)(tsl[PROBE_R1] - tsl[PROBE_R0]) * 0.01f;
        if (threadIdx.x == 0) out[0] += ta * 0.1f;
        const float dl = sqrtf(tr * 0.02f);
        out[1024 + threadIdx.x] += dl; out[1536 + threadIdx.x] += dl;
    }
#endif
}
#undef ctl
#undef modp
#undef mod
#undef tab
#undef kmean
#undef gkl
#undef topw
#undef dest
#undef list
#undef WinT
#undef WpaT
#undef WpbT
#undef WoutT
#undef WdT
#undef WguT
#undef XN
#undef Qm
#undef Km
#undef Vm
#undef QBb
#undef KBb
#undef VBb
#undef Rb
#undef GT
#undef MIX
#undef H2
#undef ACT
#undef YA
#undef YBr
#undef ya
#undef yb
#undef VT
#undef PO8
#undef ML
#undef DEC
#undef LST

extern "C" void kernel_launch(void* const* d_in, const int* in_sizes, int n_in, void* d_out, int out_size, void* d_ws, size_t ws_size, hipStream_t stream) {
    static int grid = 0;
    if (grid == 0) {
        if (n_in != 23 || out_size != TT * DM || ws_size < WS_NEED) { fprintf(stderr, "kernel_launch: unexpected shapes (n_in %d out %d ws %zu)\n", n_in, out_size, ws_size); grid = -1; return; }
        int dev = 0, cus = 0, per_cu = 0;
        (void)hipGetDevice(&dev); (void)hipDeviceGetAttribute(&cus, hipDeviceAttributeMultiprocessorCount, dev);
        if (hipFuncSetAttribute((const void*)mega_fwd, hipFuncAttributeMaxDynamicSharedMemorySize, LDS_BYTES) != hipSuccess) { fprintf(stderr, "kernel_launch: hipFuncSetAttribute failed\n"); grid = -1; return; }
        if (hipOccupancyMaxActiveBlocksPerMultiprocessor(&per_cu, (const void*)mega_fwd, NTHR, LDS_BYTES) != hipSuccess || per_cu < 1) { fprintf(stderr, "kernel_launch: occupancy query failed (%d)\n", per_cu); (void)hipGetLastError(); grid = -1; return; }
        grid = cus;
    }
    if (grid < 0) return;
    (void)hipMemsetAsync((char*)d_ws + WS_CTL, 0, 65536, stream);
    Args a{};
    for (int i = 0; i < 23; ++i) a.in[i] = (const float*)d_in[i];
    a.out = (float*)d_out; a.ws = (unsigned char*)d_ws;
    void* kargs[] = {&a};
    hipError_t e = hipLaunchCooperativeKernel((const void*)mega_fwd, dim3(grid), dim3(NTHR), kargs, LDS_BYTES, stream);
    if (e != hipSuccess) fprintf(stderr, "cooperative launch failed: %s (grid %d)\n", hipGetErrorString(e), grid);
}
```
